# Optimizing an MI355X kernel written in HIP

```python
import math
import jax
import jax.numpy as jnp
from jax import lax
import numpy as np

D_MODEL = 1024
BATCH = 8
SEQ = 4096
DEPTH = 2

CTX_LEN = 256
GRID_W = 64
D_FF = 2816
CHUNK = 128
LN_EPS = 1e-5
N_MOD = 9

NA_HEADS = 8
NA_HEAD_DIM = 64
NA_WIN_H = 8
NA_WIN_W = 16
NA_WIDTH = NA_HEADS * NA_HEAD_DIM
ML_HEADS = 4
ML_HEAD_DIM = 128
ML_WIDTH = ML_HEADS * ML_HEAD_DIM
ML_CONV = 5
S5_GROUP = 16
S5_GROUPS = 32
S5_WIDTH = S5_GROUP * S5_GROUPS
S5_STATE = 64
RET_HEADS = 4
RET_HEAD_DIM = 128
RET_WIDTH = RET_HEADS * RET_HEAD_DIM
ROPE_BASE = 10000.0

EV_SIZES = (NA_WIDTH, NA_WIDTH, NA_WIDTH, ML_WIDTH, ML_WIDTH, ML_WIDTH, 2 * ML_HEADS, 2 * ML_HEADS)
OD_SIZES = (S5_WIDTH, RET_WIDTH, RET_WIDTH, RET_WIDTH, RET_WIDTH)
EV_IN = sum(EV_SIZES)
OD_IN = sum(OD_SIZES)
MIX_WIDTH = NA_WIDTH + ML_WIDTH

F32 = jnp.float32

kernel_name = 'hybrid_dit_natten_mlstm_s5_retention'


def layer_norm(h, g, b):
    hf = h.astype(F32)
    mu = jnp.mean(hf, -1, keepdims=True)
    var = jnp.mean(jnp.square(hf - mu), -1, keepdims=True)
    return ((hf - mu) * lax.rsqrt(var + LN_EPS) * g.astype(F32) + b.astype(F32)).astype(h.dtype)


def modulate(h, mod, j):
    return h * (1.0 + mod[..., 3 * j + 1, :, :]) + mod[..., 3 * j, :, :]


def gate(mod, j):
    return mod[..., 3 * j + 2, :, :]


def swiglu(h, w_gate, w_up, w_down):
    return (jax.nn.silu(h @ w_gate) * (h @ w_up)) @ w_down


def half_ffn(h, mod, j, w, g, b, alpha):
    y = swiglu(modulate(h, mod, j), *w)
    return layer_norm(alpha * h + 0.5 * gate(mod, j) * y, g, b)


def split_cols(z, sizes):
    parts, off = [], 0
    for s in sizes:
        parts.append(z[..., off:off + s])
        off += s
    return parts


def head_norm(h, w):
    bsz, nh, t, d = h.shape
    mu = jnp.mean(h, -1, keepdims=True)
    var = jnp.mean(jnp.square(h - mu), -1, keepdims=True)
    hn = (h - mu) * lax.rsqrt(var + LN_EPS)
    return hn.transpose(0, 2, 1, 3).reshape(bsz, t, nh * d) * w.astype(F32)


def to_chunks(a, axis):
    t = a.shape[axis]
    a = a.reshape(a.shape[:axis] + (t // CHUNK, CHUNK) + a.shape[axis + 1:])
    return jnp.moveaxis(a, axis, 0)


def from_chunks(a, axis):
    a = jnp.moveaxis(a, 0, axis)
    return a.reshape(a.shape[:axis] + (a.shape[axis] * a.shape[axis + 1],) + a.shape[axis + 2:])


def bidir_scan(scan_fn, ctx_xs, lat_xs, dir_params, init_state, axis):
    ys_c, ys_l = [], []
    for d in range(2):
        flip = (lambda a: jnp.flip(a, axis)) if d == 1 else (lambda a: a)
        y_c, state = scan_fn(*[flip(a) for a in ctx_xs[d]], *dir_params[d], init_state)
        y_l, _ = scan_fn(*[flip(a) for a in lat_xs[d]], *dir_params[d], state)
        ys_c.append(flip(y_c))
        ys_l.append(flip(y_l))
    return ys_c[0] + ys_c[1], ys_l[0] + ys_l[1]


def context_attention(q, k, v):
    s = jnp.einsum('bqhd,bkhd->bhqk', q, k) * (q.shape[-1] ** -0.5)
    p = jax.nn.softmax(s.astype(F32), axis=-1).astype(v.dtype)
    o = jnp.einsum('bhqk,bkhd->bqhd', p, v)
    return o.reshape(o.shape[0], o.shape[1], -1)


def neighbourhood_attention(q, k, v, k_ctx, v_ctx, rpb):
    bsz, seq, nh, dh = q.shape
    rows = seq // GRID_W
    kh, kw = min(NA_WIN_H, rows), NA_WIN_W
    n_loc = kh * kw
    grid = lambda a: a.reshape(bsz, rows, GRID_W, nh, dh).transpose(0, 3, 1, 2, 4)
    kg, vg = grid(k), grid(v)
    q_rows = q.reshape(bsz, rows, GRID_W, nh, dh).transpose(1, 0, 3, 2, 4) * (dh ** -0.5)
    kc, vc = k_ctx.transpose(0, 2, 1, 3), v_ctx.transpose(0, 2, 1, 3)
    cols = jnp.arange(GRID_W)
    col_idx = jnp.clip(cols - kw // 2, 0, GRID_W - kw)[:, None] + jnp.arange(kw)[None, :]
    col_off = col_idx - cols[:, None] + (NA_WIN_W - 1)

    def one_row(args):
        qr, r = args
        rs = jnp.clip(r - kh // 2, 0, rows - kh)
        kwin = jnp.take(lax.dynamic_slice_in_dim(kg, rs, kh, axis=2), col_idx, axis=3)
        vwin = jnp.take(lax.dynamic_slice_in_dim(vg, rs, kh, axis=2), col_idx, axis=3)
        row_off = rs + jnp.arange(kh) - r + (NA_WIN_H - 1)
        bias = rpb[:, row_off[:, None, None], col_off[None, :, :]].transpose(0, 2, 1, 3)
        s_loc = jnp.einsum('bhqd,bhrqwd->bhqrw', qr, kwin) + bias
        s_ctx = jnp.einsum('bhqd,bhcd->bhqc', qr, kc)
        logits = jnp.concatenate([s_loc.reshape(bsz, nh, GRID_W, n_loc), s_ctx], -1).astype(F32)
        p = jax.nn.softmax(logits, axis=-1).astype(v.dtype)
        p_loc = p[..., :n_loc].reshape(bsz, nh, GRID_W, kh, kw)
        return (jnp.einsum('bhqrw,bhrqwd->bhqd', p_loc, vwin)
                + jnp.einsum('bhqc,bhcd->bhqd', p[..., n_loc:], vc))

    out = lax.map(one_row, (q_rows, jnp.arange(rows)))
    return out.transpose(1, 0, 3, 2, 4).reshape(bsz, seq, nh * dh)


def mlstm_scan(q, k, v, i_pre, log_f, state):
    tri = jnp.tril(jnp.ones((CHUNK, CHUNK), dtype=bool))

    def step(carry, xs):
        c_mat, n_vec, m = carry
        qc, kc, vc, ic, fc = xs
        b = jnp.cumsum(fc, axis=-1)
        dlog = jnp.where(tri, b[..., :, None] - b[..., None, :] + ic[..., None, :], -jnp.inf)
        inter = b + m[..., None]
        m_t = jnp.maximum(inter, jnp.max(dlog, axis=-1))
        s = jnp.einsum('bhtd,bhsd->bhts', qc, kc) * jnp.exp(dlog - m_t[..., None])
        w_inter = jnp.exp(inter - m_t)
        num = (jnp.einsum('bhts,bhsd->bhtd', s, vc)
               + w_inter[..., None] * jnp.einsum('bhvk,bhtk->bhtv', c_mat, qc))
        den = jnp.sum(s, -1) + w_inter * jnp.einsum('bhk,bhtk->bht', n_vec, qc)
        h = num / jnp.maximum(jnp.abs(den), jnp.exp(-m_t))[..., None]
        b_last = b[..., -1]
        w_log = b_last[..., None] - b + ic
        m_new = jnp.maximum(b_last + m, jnp.max(w_log, -1))
        carry_decay = jnp.exp(b_last + m - m_new)
        w_in = jnp.exp(w_log - m_new[..., None])
        c_new = carry_decay[..., None, None] * c_mat + jnp.einsum('bhsv,bhsk->bhvk', vc * w_in[..., None], kc)
        n_new = carry_decay[..., None] * n_vec + jnp.einsum('bhs,bhsk->bhk', w_in, kc)
        return (c_new, n_new, m_new), h

    xs = tuple(to_chunks(a, 2) for a in (q, k, v, i_pre, log_f))
    state, hs = lax.scan(step, state, xs)
    return from_chunks(hs, 2), state


def centred_depthwise_conv(x, w, b):
    y = lax.conv_general_dilated(x, w[:, None, :], window_strides=(1,), padding='SAME',
                                 dimension_numbers=('NWC', 'WIO', 'NWC'), feature_group_count=x.shape[-1])
    return y + b


def mlstm_prepare(parts, conv_w, conv_b, wq, wk, i_bias, f_bias):
    xm, zv, zo, zi, zf = parts
    bsz, t, _ = xm.shape
    xc = jax.nn.silu(centred_depthwise_conv(xm, conv_w, conv_b)).astype(F32)
    xc = xc.reshape(bsz, t, ML_HEADS, ML_HEAD_DIM)
    q = jnp.einsum('bthd,hde->bhte', xc, wq.astype(F32))
    k = jnp.einsum('bthd,hde->bhte', xc, wk.astype(F32)) * (ML_HEAD_DIM ** -0.5)
    v = zv.astype(F32).reshape(bsz, t, ML_HEADS, ML_HEAD_DIM).transpose(0, 2, 1, 3)
    i_pre = (zi.astype(F32).reshape(bsz, t, 2, ML_HEADS) + i_bias.astype(F32)).transpose(2, 0, 3, 1)
    log_f = jax.nn.log_sigmoid(zf.astype(F32).reshape(bsz, t, 2, ML_HEADS)
                               + f_bias.astype(F32)).transpose(2, 0, 3, 1)
    xs = [(q, k, v, i_pre[d], log_f[d]) for d in range(2)]
    return xs, jax.nn.sigmoid(zo.astype(F32))


def even_mixer(zc, zl, rpb, conv_w, conv_b, wq, wk, i_bias, f_bias, gn_w):
    pc, pl = split_cols(zc, EV_SIZES), split_cols(zl, EV_SIZES)
    heads = lambda a: a.reshape(a.shape[0], a.shape[1], NA_HEADS, NA_HEAD_DIM)
    na_c = context_attention(heads(pc[0]), heads(pc[1]), heads(pc[2]))
    na_l = neighbourhood_attention(heads(pl[0]), heads(pl[1]), heads(pl[2]),
                                   heads(pc[1]), heads(pc[2]), rpb)
    xs_c, o_c = mlstm_prepare(pc[3:], conv_w, conv_b, wq, wk, i_bias, f_bias)
    xs_l, o_l = mlstm_prepare(pl[3:], conv_w, conv_b, wq, wk, i_bias, f_bias)
    bsz = zl.shape[0]
    init = (jnp.zeros((bsz, ML_HEADS, ML_HEAD_DIM, ML_HEAD_DIM), F32),
            jnp.zeros((bsz, ML_HEADS, ML_HEAD_DIM), F32),
            jnp.zeros((bsz, ML_HEADS), F32))
    h_c, h_l = bidir_scan(mlstm_scan, xs_c, xs_l, ((), ()), init, 2)
    ml_c = (o_c * head_norm(h_c, gn_w)).astype(zc.dtype)
    ml_l = (o_l * head_norm(h_l, gn_w)).astype(zl.dtype)
    return jnp.concatenate([na_c, ml_c], -1), jnp.concatenate([na_l, ml_l], -1)


def s5_scan(u, lam_re, lam_im, log_dt, b_re, b_im, c_re, c_im, state):
    dt = jnp.exp(log_dt)[:, None]
    zr, zi = lam_re * dt, lam_im * dt
    mag = jnp.exp(zr)
    a_re, a_im = mag * jnp.cos(zi), mag * jnp.sin(zi)
    lam_sq = jnp.square(lam_re) + jnp.square(lam_im)
    e_re = ((a_re - 1.0) * lam_re + a_im * lam_im) / lam_sq
    e_im = (a_im * lam_re - (a_re - 1.0) * lam_im) / lam_sq
    bb_re = e_re[..., None] * b_re - e_im[..., None] * b_im
    bb_im = e_re[..., None] * b_im + e_im[..., None] * b_re
    steps = jnp.arange(1, CHUNK + 1, dtype=F32)[:, None, None]
    pmag = jnp.exp(steps * zr)
    p_re, p_im = pmag * jnp.cos(steps * zi), pmag * jnp.sin(steps * zi)

    def combine(e1, e2):
        a1r, a1i, b1r, b1i = e1
        a2r, a2i, b2r, b2i = e2
        return (a2r * a1r - a2i * a1i, a2r * a1i + a2i * a1r,
                a2r * b1r - a2i * b1i + b2r, a2r * b1i + a2i * b1r + b2i)

    def step(carry, uc):
        x0r, x0i = carry
        bu_re = jnp.einsum('blgq,gpq->blgp', uc, bb_re)
        bu_im = jnp.einsum('blgq,gpq->blgp', uc, bb_im)
        _, _, xr, xi = lax.associative_scan(
            combine, (jnp.broadcast_to(a_re, bu_re.shape), jnp.broadcast_to(a_im, bu_im.shape), bu_re, bu_im),
            axis=1)
        xr, xi = (xr + p_re * x0r[:, None] - p_im * x0i[:, None],
                  xi + p_re * x0i[:, None] + p_im * x0r[:, None])
        y = jnp.einsum('blgp,gqp->blgq', xr, c_re) - jnp.einsum('blgp,gqp->blgq', xi, c_im)
        return (xr[:, -1], xi[:, -1]), y

    state, ys = lax.scan(step, state, to_chunks(u, 1))
    return from_chunks(ys, 1), state


def retention_scan(q, k, v, log_g, state):
    j = jnp.arange(CHUNK, dtype=F32)
    rel = j[:, None] - j[None, :]
    dmat = jnp.where(rel >= 0, jnp.exp(jnp.maximum(rel, 0.0) * log_g[:, None, None]), 0.0)
    q_dec = jnp.exp((j + 1.0) * log_g[:, None])[..., None]
    k_dec = jnp.exp((CHUNK - 1.0 - j) * log_g[:, None])[..., None]
    c_dec = jnp.exp(CHUNK * log_g)[:, None, None]

    def step(r, xs):
        qc, kc, vc = xs
        inner = jnp.einsum('bhts,bhsv->bhtv', jnp.einsum('bhtd,bhsd->bhts', qc, kc) * dmat, vc)
        cross = jnp.einsum('bhtd,bhdv->bhtv', qc * q_dec, r)
        r_new = c_dec * r + jnp.einsum('bhsd,bhsv->bhdv', kc * k_dec, vc)
        return r_new, inner + cross

    xs = tuple(to_chunks(a, 2) for a in (q, k, v))
    state, ys = lax.scan(step, state, xs)
    return from_chunks(ys, 2), state


def axial_rope(x, pos_row, pos_col):
    d = x.shape[-1]
    half, nf = d // 2, d // 4
    freqs = ROPE_BASE ** (-jnp.arange(nf, dtype=F32) / nf)

    def rotate(xp, pos):
        ang = pos.astype(F32)[:, None] * freqs
        cos, sin = jnp.cos(ang)[None, :, None, :], jnp.sin(ang)[None, :, None, :]
        x1, x2 = xp[..., :nf], xp[..., nf:]
        return jnp.concatenate([x1 * cos - x2 * sin, x2 * cos + x1 * sin], -1)

    return jnp.concatenate([rotate(x[..., :half], pos_row), rotate(x[..., half:], pos_col)], -1)


def odd_mixer(zc, zl, pos_row, pos_col, lam_re, lam_im, log_dt, b_re, b_im, c_re, c_im,
              d_skip, glu_w, glu_b, decay_logit, gn_w):
    pc, pl = split_cols(zc, OD_SIZES), split_cols(zl, OD_SIZES)
    bsz = zl.shape[0]
    groups = lambda a: a.astype(F32).reshape(a.shape[0], a.shape[1], S5_GROUPS, S5_GROUP)
    uc, ul = groups(pc[0]), groups(pl[0])
    s5_p = [tuple(p[d].astype(F32) for p in (lam_re, lam_im, log_dt, b_re, b_im, c_re, c_im)) for d in range(2)]
    s5_init = (jnp.zeros((bsz, S5_GROUPS, S5_STATE), F32), jnp.zeros((bsz, S5_GROUPS, S5_STATE), F32))
    yc, yl = bidir_scan(s5_scan, [(uc,), (uc,)], [(ul,), (ul,)], s5_p, s5_init, 1)

    def s5_out(y, u):
        y = jax.nn.gelu(y + d_skip.astype(F32) * u)
        y = y.reshape(y.shape[0], y.shape[1], S5_WIDTH)
        return y * jax.nn.sigmoid(y @ glu_w.astype(F32) + glu_b.astype(F32))

    heads = lambda a: a.astype(F32).reshape(a.shape[0], a.shape[1], RET_HEADS, RET_HEAD_DIM)
    bhtd = lambda a: a.transpose(0, 2, 1, 3)
    k_scale = RET_HEAD_DIM ** -0.5
    rc_xs = (bhtd(heads(pc[1])), bhtd(heads(pc[2])) * k_scale, bhtd(heads(pc[3])))
    rl_xs = (bhtd(axial_rope(heads(pl[1]), pos_row, pos_col)),
             bhtd(axial_rope(heads(pl[2]), pos_row, pos_col)) * k_scale,
             bhtd(heads(pl[3])))
    log_g = jax.nn.log_sigmoid(decay_logit.astype(F32))
    ret_init = jnp.zeros((bsz, RET_HEADS, RET_HEAD_DIM, RET_HEAD_DIM), F32)
    rc, rl = bidir_scan(retention_scan, [rc_xs, rc_xs], [rl_xs, rl_xs], [(log_g[0],), (log_g[1],)], ret_init, 2)
    ret_c = jax.nn.silu(pc[4].astype(F32)) * head_norm(rc, gn_w)
    ret_l = jax.nn.silu(pl[4].astype(F32)) * head_norm(rl, gn_w)
    out_c = jnp.concatenate([s5_out(yc, uc), ret_c], -1).astype(zc.dtype)
    out_l = jnp.concatenate([s5_out(yl, ul), ret_l], -1).astype(zl.dtype)
    return out_c, out_l


def setup_inputs(seed: int = 0) -> dict:
    key = jax.random.key(seed)
    ks = jax.random.split(key, 40)
    n_ev, n_od = (DEPTH + 1) // 2, DEPTH // 2
    beta = (8.0 * DEPTH) ** -0.25
    D = D_MODEL
    nrm = lambda i, shape, s: jax.random.normal(ks[i], shape, F32) * s
    ones_n = lambda i, shape: 1.0 + nrm(i, shape, 0.02)
    return {
        'x': nrm(0, (BATCH, SEQ, D), 1.0),
        'c': nrm(1, (BATCH, D), 1.0),
        'ctx': nrm(2, (BATCH, CTX_LEN, D), 1.0),
        'c_ctx': nrm(3, (D,), 1.0),
        'ada_w': nrm(4, (DEPTH, D, N_MOD * D), 0.5 * D ** -0.5),
        'ada_b': nrm(5, (DEPTH, N_MOD * D), 0.02),
        'ffn_w_gate': nrm(6, (DEPTH, 2, D, D_FF), D ** -0.5),
        'ffn_w_up': nrm(7, (DEPTH, 2, D, D_FF), D ** -0.5),
        'ffn_w_down': nrm(8, (DEPTH, 2, D_FF, D), beta * D_FF ** -0.5),
        'ln_g': ones_n(9, (DEPTH, 3, D)),
        'ln_b': nrm(10, (DEPTH, 3, D), 0.02),
        'ev_w_in': nrm(11, (n_ev, D, EV_IN), D ** -0.5),
        'ev_w_out': nrm(12, (n_ev, MIX_WIDTH, D), beta * MIX_WIDTH ** -0.5),
        'na_rpb': nrm(13, (n_ev, NA_HEADS, 2 * NA_WIN_H - 1, 2 * NA_WIN_W - 1), 0.1),
        'ml_conv_w': nrm(14, (n_ev, ML_CONV, ML_WIDTH), ML_CONV ** -0.5),
        'ml_conv_b': nrm(15, (n_ev, ML_WIDTH), 0.02),
        'ml_wq': nrm(16, (n_ev, ML_HEADS, ML_HEAD_DIM, ML_HEAD_DIM), ML_HEAD_DIM ** -0.5),
        'ml_wk': nrm(17, (n_ev, ML_HEADS, ML_HEAD_DIM, ML_HEAD_DIM), ML_HEAD_DIM ** -0.5),
        'ml_i_bias': nrm(18, (n_ev, 2, ML_HEADS), 0.1),
        'ml_f_bias': jnp.linspace(3.0, 6.0, ML_HEADS, dtype=F32) + nrm(19, (n_ev, 2, ML_HEADS), 0.1),
        'ml_gn_w': ones_n(20, (n_ev, ML_WIDTH)),
        'od_w_in': nrm(21, (n_od, D, OD_IN), D ** -0.5),
        'od_w_out': nrm(22, (n_od, MIX_WIDTH, D), beta * MIX_WIDTH ** -0.5),
        's5_lam_re': -0.5 + nrm(23, (n_od, 2, S5_GROUPS, S5_STATE), 0.01),
        's5_lam_im': math.pi * jnp.arange(S5_STATE, dtype=F32) + nrm(24, (n_od, 2, S5_GROUPS, S5_STATE), 0.01),
        's5_log_dt': jax.random.uniform(ks[25], (n_od, 2, S5_GROUPS), F32, math.log(1e-3), math.log(1e-1)),
        's5_b_re': nrm(26, (n_od, 2, S5_GROUPS, S5_STATE, S5_GROUP), (2.0 * S5_GROUP) ** -0.5),
        's5_b_im': nrm(27, (n_od, 2, S5_GROUPS, S5_STATE, S5_GROUP), (2.0 * S5_GROUP) ** -0.5),
        's5_c_re': nrm(28, (n_od, 2, S5_GROUPS, S5_GROUP, S5_STATE), 0.5),
        's5_c_im': nrm(29, (n_od, 2, S5_GROUPS, S5_GROUP, S5_STATE), 0.5),
        's5_d': nrm(30, (n_od, S5_GROUPS, S5_GROUP), 0.5),
        's5_glu_w': nrm(31, (n_od, S5_WIDTH, S5_WIDTH), S5_WIDTH ** -0.5),
        's5_glu_b': nrm(32, (n_od, S5_WIDTH), 0.02),
        'ret_decay_logit': (jnp.log(2.0 ** (5.0 + jnp.arange(RET_HEADS, dtype=F32)) - 1.0)
                            + nrm(33, (n_od, 2, RET_HEADS), 0.01)),
        'ret_gn_w': ones_n(34, (n_od, RET_WIDTH)),
    }


def reference(x, c, ctx, c_ctx, ada_w, ada_b, ffn_w_gate, ffn_w_up, ffn_w_down, ln_g, ln_b,
              ev_w_in, ev_w_out, na_rpb, ml_conv_w, ml_conv_b, ml_wq, ml_wk, ml_i_bias, ml_f_bias, ml_gn_w,
              od_w_in, od_w_out, s5_lam_re, s5_lam_im, s5_log_dt, s5_b_re, s5_b_im, s5_c_re, s5_c_im,
              s5_d, s5_glu_w, s5_glu_b, ret_decay_logit, ret_gn_w):
    bsz, seq, dm = x.shape
    t = jnp.arange(seq)
    pos_row, pos_col = t // GRID_W, t % GRID_W
    alpha = (2.0 * DEPTH) ** 0.25
    silu_c, silu_cc = jax.nn.silu(c), jax.nn.silu(c_ctx)
    cx = ctx
    for l in range(DEPTH):
        e = l // 2
        last = l == DEPTH - 1
        mod_l = (silu_c @ ada_w[l] + ada_b[l]).reshape(bsz, N_MOD, 1, dm)
        mod_c = (silu_cc @ ada_w[l] + ada_b[l]).reshape(N_MOD, 1, dm)
        ffn_a = (ffn_w_gate[l, 0], ffn_w_up[l, 0], ffn_w_down[l, 0])
        ffn_b = (ffn_w_gate[l, 1], ffn_w_up[l, 1], ffn_w_down[l, 1])
        x = half_ffn(x, mod_l, 0, ffn_a, ln_g[l, 0], ln_b[l, 0], alpha)
        cx = half_ffn(cx, mod_c, 0, ffn_a, ln_g[l, 0], ln_b[l, 0], alpha)
        hl, hc = modulate(x, mod_l, 1), modulate(cx, mod_c, 1)
        if l % 2 == 0:
            yc, yl = even_mixer(hc @ ev_w_in[e], hl @ ev_w_in[e], na_rpb[e], ml_conv_w[e], ml_conv_b[e],
                                ml_wq[e], ml_wk[e], ml_i_bias[e], ml_f_bias[e], ml_gn_w[e])
            w_out = ev_w_out[e]
        else:
            yc, yl = odd_mixer(hc @ od_w_in[e], hl @ od_w_in[e], pos_row, pos_col,
                               s5_lam_re[e], s5_lam_im[e], s5_log_dt[e], s5_b_re[e], s5_b_im[e],
                               s5_c_re[e], s5_c_im[e], s5_d[e], s5_glu_w[e], s5_glu_b[e],
                               ret_decay_logit[e], ret_gn_w[e])
            w_out = od_w_out[e]
        x = layer_norm(alpha * x + gate(mod_l, 1) * (yl.astype(x.dtype) @ w_out), ln_g[l, 1], ln_b[l, 1])
        x = half_ffn(x, mod_l, 2, ffn_b, ln_g[l, 2], ln_b[l, 2], alpha)
        if not last:
            cx = layer_norm(alpha * cx + gate(mod_c, 1) * (yc.astype(cx.dtype) @ w_out), ln_g[l, 1], ln_b[l, 1])
            cx = half_ffn(cx, mod_c, 2, ffn_b, ln_g[l, 2], ln_b[l, 2], alpha)
    return x
```

```cpp
#include <hip/hip_runtime.h>
#include <hip/hip_cooperative_groups.h>
#include <stdint.h>
#include <stdio.h>
namespace cg = cooperative_groups;

#ifndef MK_COOP
#define MK_COOP 1
#endif

typedef unsigned short bf16_t;
typedef __attribute__((ext_vector_type(8))) short bf16x8;
typedef __attribute__((ext_vector_type(4))) short bf16x4;
typedef __attribute__((ext_vector_type(4))) float f32x4;

constexpr int NL = 32768, NT = 34816, LDZ = 3088;
constexpr int PK = 136;
constexpr int LDS_BYTES = 155648;
constexpr int NPHASE = 28;
#ifndef PROBE_N
#define PROBE_N 0
#define PROBE_PH 0
#endif

struct Params {
  const float *x, *c, *ctx, *c_ctx, *ada_w, *ada_b, *wg, *wu, *wd, *ln_g, *ln_b,
      *ev_w_in, *ev_w_out, *rpb, *conv_w, *conv_b, *wq, *wk, *i_bias, *f_bias, *ml_gn,
      *od_w_in, *od_w_out, *lam_re, *lam_im, *log_dt, *b_re, *b_im, *c_re, *c_im,
      *s5_d, *glu_w, *glu_b, *decay_logit, *ret_gn;
  float* out;
  float *mod, *rope, *hsc, *gates;
  bf16_t *wgu, *wdn, *wevin, *wodin, *wevout, *wodout, *wqk, *wglu;
  bf16_t *z, *ab, *och, *vt;
  float* stats;
  unsigned* bar;
};

typedef const __attribute__((address_space(4))) Params CParams;
typedef CParams& PRef;
__device__ __forceinline__ CParams* kparams() {
  CParams* q = (CParams*)__builtin_amdgcn_kernarg_segment_ptr();
  asm volatile("" : "+s"(q));
  return q;
}

#define LAS __attribute__((address_space(3)))
extern __shared__ __attribute__((aligned(16))) char smem[];
__device__ __forceinline__ int tidx() { int t = __builtin_amdgcn_workitem_id_x(); asm volatile("" : "+v"(t)); return t; }

__device__ __forceinline__ bf16_t f2bf(float f) {
  uint32_t u = __float_as_uint(f);
  u += 0x7fffu + ((u >> 16) & 1u);
  return (bf16_t)(u >> 16);
}
typedef float f32x2_ __attribute__((ext_vector_type(2)));
typedef __bf16 bf16x2_ __attribute__((ext_vector_type(2)));
__device__ __forceinline__ uint32_t cvt_pk_bf16(float lo, float hi) {
  f32x2_ v = {lo, hi};
  return __builtin_bit_cast(uint32_t, __builtin_convertvector(v, bf16x2_));
}
__device__ __forceinline__ float bf2f(bf16_t h) { return __uint_as_float(((uint32_t)h) << 16); }
__device__ __forceinline__ float sigmoidf_(float x) { return __builtin_amdgcn_rcpf(1.0f + __expf(-x)); }
__device__ __forceinline__ float siluf_(float x) { return x * __builtin_amdgcn_rcpf(1.0f + __expf(-x)); }
__device__ __forceinline__ float log_sigmoidf_(float x) { return fminf(x, 0.0f) - log1pf(__expf(-fabsf(x))); }
typedef __attribute__((ext_vector_type(2))) uint32_t u32x2;
typedef __attribute__((ext_vector_type(4))) uint32_t u32x4;
__device__ __forceinline__ bf16x4 pack4(f32x4 a) {
  u32x2 w; w[0] = cvt_pk_bf16(a[0], a[1]); w[1] = cvt_pk_bf16(a[2], a[3]);
  return __builtin_bit_cast(bf16x4, w);
}
__device__ __forceinline__ bf16x8 pack8(const float* a) {
  u32x4 w; w[0] = cvt_pk_bf16(a[0], a[1]); w[1] = cvt_pk_bf16(a[2], a[3]); w[2] = cvt_pk_bf16(a[4], a[5]); w[3] = cvt_pk_bf16(a[6], a[7]);
  return __builtin_bit_cast(bf16x8, w);
}
__device__ __forceinline__ float* hs_ptr(PRef p, int row) {
  return row < NL ? p.out + (size_t)row * 1024 : p.hsc + (size_t)(row - NL) * 1024;
}
__device__ __forceinline__ int mod_row(int row) { return row < NL ? (row >> 12) : 8; }
__device__ __forceinline__ int chain_row(int b, int d, int pos) {
  if (pos < 256) { int t = d ? 255 - pos : pos; return NL + b * 256 + t; }
  int t = pos - 256; if (d) t = 4095 - t; return b * 4096 + t;
}
__device__ __forceinline__ float wave_sum(float v) {
#pragma unroll
  for (int o = 32; o > 0; o >>= 1) v += __shfl_xor(v, o);
  return v;
}
__device__ __forceinline__ void sincos_d(double x, float* s, float* c) {
  const double TWO_PI = 6.283185307179586476925;
  double n = rint(x * (1.0 / TWO_PI));
  double r = x - n * TWO_PI;
  double r2 = r * r, ts = r, tc = 1.0, ss = r, cc = 1.0;
#pragma unroll
  for (int i = 1; i <= 13; ++i) {
    tc *= -r2 * (1.0 / (double)((2 * i - 1) * (2 * i)));  cc += tc;
    ts *= -r2 * (1.0 / (double)((2 * i) * (2 * i + 1)));  ss += ts;
  }
  *s = (float)ss; *c = (float)cc;
}

template <int GU>
__device__ __forceinline__ void conv_plain(const float* __restrict__ src, const float* __restrict__ src2, int ld, bf16_t* __restrict__ dst, int N, int K, int rot) {
  const int nb = gridDim.x;
  const int items = N * (K >> 4);
  for (int it = ((blockIdx.x + rot) % nb) * 512 + tidx(); it < items; it += nb * 512) {
    const int n = it % N, kg = it / N;
    const float* sp = src; int scol = n;
    if (GU) { scol = (n >> 8) * 128 + (n & 127); sp = ((n >> 7) & 1) ? src2 : src; }
    sp += (size_t)(kg * 16) * ld + scol;
    float v[16];
#pragma unroll
    for (int i = 0; i < 16; ++i) v[i] = sp[(size_t)i * ld];
    bf16_t* dp = dst + (size_t)n * K + kg * 16;
    *(bf16x8*)dp = pack8(v); *(bf16x8*)(dp + 8) = pack8(v + 8);
  }
}

__device__ __forceinline__ void phase_setup(PRef p) {
  const int tid = tidx(), nb = gridDim.x, bid = blockIdx.x;
  {
    float* ss = (float*)smem;
    float* red = ss + 9216;
    for (int i = tid; i < 9216; i += 512) {
      int r = i >> 10, k = i & 1023;
      float v = r < 8 ? p.c[r * 1024 + k] : p.c_ctx[k];
      ss[i] = siluf_(v);
    }
    __syncthreads();
    for (int task = bid; task < 288; task += nb) {
      int l = task / 144, j0 = (task % 144) * 64, jj = tid & 63, kg = tid >> 6;
      float acc[9];
#pragma unroll
      for (int r = 0; r < 9; ++r) acc[r] = 0.f;
      const float* w = p.ada_w + ((size_t)l * 1024 + kg * 128) * 9216 + j0 + jj;
      for (int k = 0; k < 128; ++k) {
        float wv = w[(size_t)k * 9216];
#pragma unroll
        for (int r = 0; r < 9; ++r) acc[r] += ss[r * 1024 + kg * 128 + k] * wv;
      }
#pragma unroll
      for (int r = 0; r < 9; ++r) red[(kg * 9 + r) * 64 + jj] = acc[r];
      __syncthreads();
      for (int i = tid; i < 576; i += 512) {
        int r = i >> 6, j2 = i & 63;
        float s = p.ada_b[l * 9216 + j0 + j2];
#pragma unroll
        for (int g = 0; g < 8; ++g) s += red[(g * 9 + r) * 64 + j2];
        p.mod[(size_t)(l * 9 + r) * 9216 + j0 + j2] = s;
      }
      __syncthreads();
    }
  }
  if (bid == 0) for (int i = tid; i < 3456; i += 512) p.bar[i] = 0u;
  for (int i = bid * 512 + tid; i < 2048; i += nb * 512) {
    int pos = i >> 5, fi = i & 31;
    float fr = expf(-(float)fi * (1.0f / 32.0f) * 9.210340371976184f);
    float s, c;
    sincos_d((double)pos * (double)fr, &s, &c);
    p.rope[i * 2] = c; p.rope[i * 2 + 1] = s;
  }
  for (int li = 0; li < 4; ++li) {
    conv_plain<1>(p.wg + (size_t)li * 1024 * 2816, p.wu + (size_t)li * 1024 * 2816, 2816, p.wgu + (size_t)li * 5632 * 1024, 5632, 1024, li * 37);
    conv_plain<0>(p.wd + (size_t)li * 2816 * 1024, nullptr, 1024, p.wdn + (size_t)li * 1024 * 2816, 1024, 2816, li * 61 + 13);
  }
  conv_plain<0>(p.ev_w_in, nullptr, 3088, p.wevin, 3088, 1024, 5);
  for (int i = bid * 512 + tid; i < 240 * 1024; i += nb * 512) p.wevin[(size_t)3088 * 1024 + i] = (bf16_t)0;
  conv_plain<0>(p.od_w_in, nullptr, 2560, p.wodin, 2560, 1024, 77);
  conv_plain<0>(p.ev_w_out, nullptr, 1024, p.wevout, 1024, 1024, 131);
  conv_plain<0>(p.od_w_out, nullptr, 1024, p.wodout, 1024, 1024, 171);
  conv_plain<0>(p.glu_w, nullptr, 512, p.wglu, 512, 512, 201);
  for (int i = bid * 512 + tid; i < 1024 * 512; i += nb * 512) {
    int k = i >> 10, n = i & 1023;
    int hh = (n & 511) >> 7, e = n & 127, kh = k >> 7, dd = k & 127;
    float v = 0.f;
    if (kh == hh) v = n < 512 ? p.wq[(hh * 128 + dd) * 128 + e] : p.wk[(hh * 128 + dd) * 128 + e] * 0.08838834764831845f;
    p.wqk[(size_t)n * 512 + k] = f2bf(v);
  }
}

template <int MODE>
__device__ __forceinline__ void phase_prep(PRef p, int lnidx, int ml, int mj, int rbeg, int nrows, int gbid, int gnb) {
  const int lane = tidx() & 63, wid = tidx() >> 6;
  const float* g = p.ln_g + lnidx * 1024;
  const float* bb = p.ln_b + lnidx * 1024;
  constexpr int PR = 4;
  for (int row0 = rbeg + (gbid * 8 + wid) * PR; row0 < nrows; row0 += gnb * 8 * PR) {
    float4 v[PR][4];
    float* hp[PR];
#pragma unroll
    for (int r = 0; r < PR; ++r) {
      const int row = row0 + r;
      hp[r] = hs_ptr(p, row);
      const float* src = MODE == 0 ? (row < NL ? p.x + (size_t)row * 1024 : p.ctx + (size_t)(row - NL) * 1024) : hp[r];
#pragma unroll
      for (int i = 0; i < 4; ++i) v[r][i] = *(const float4*)(src + i * 256 + lane * 4);
    }
    if (MODE != 0) {
      float mu[PR], rstd[PR];
#pragma unroll
      for (int r = 0; r < PR; ++r) {
        float s = 0.f;
#pragma unroll
        for (int i = 0; i < 4; ++i) s += v[r][i].x + v[r][i].y + v[r][i].z + v[r][i].w;
        mu[r] = s;
      }
#pragma unroll
      for (int o = 32; o > 0; o >>= 1) {
#pragma unroll
        for (int r = 0; r < PR; ++r) mu[r] += __shfl_xor(mu[r], o);
      }
#pragma unroll
      for (int r = 0; r < PR; ++r) {
        mu[r] *= (1.0f / 1024.0f);
        float q = 0.f;
#pragma unroll
        for (int i = 0; i < 4; ++i) {
          v[r][i].x -= mu[r]; v[r][i].y -= mu[r]; v[r][i].z -= mu[r]; v[r][i].w -= mu[r];
          q += v[r][i].x * v[r][i].x + v[r][i].y * v[r][i].y + v[r][i].z * v[r][i].z + v[r][i].w * v[r][i].w;
        }
        rstd[r] = q;
      }
#pragma unroll
      for (int o = 32; o > 0; o >>= 1) {
#pragma unroll
        for (int r = 0; r < PR; ++r) rstd[r] += __shfl_xor(rstd[r], o);
      }
#pragma unroll
      for (int r = 0; r < PR; ++r) {
        rstd[r] = rsqrtf(rstd[r] * (1.0f / 1024.0f) + 1e-5f);
        if (MODE == 1 && lane == 0) *(float2*)(p.stats + (size_t)(row0 + r) * 2) = make_float2(mu[r], rstd[r]);
      }
#pragma unroll
      for (int i = 0; i < 4; ++i) {
        float4 gg = *(const float4*)(g + i * 256 + lane * 4), b4 = *(const float4*)(bb + i * 256 + lane * 4);
#pragma unroll
        for (int r = 0; r < PR; ++r) {
          v[r][i].x = v[r][i].x * rstd[r] * gg.x + b4.x; v[r][i].y = v[r][i].y * rstd[r] * gg.y + b4.y;
          v[r][i].z = v[r][i].z * rstd[r] * gg.z + b4.z; v[r][i].w = v[r][i].w * rstd[r] * gg.w + b4.w;
        }
      }
    }
    if (MODE == 2) {
#pragma unroll
      for (int r = 0; r < PR; ++r)
#pragma unroll
        for (int i = 0; i < 4; ++i) *(float4*)(hp[r] + i * 256 + lane * 4) = v[r][i];
    }
    if (MODE != 2) {
      const float* sh = p.mod + (size_t)(ml * 9 + mod_row(row0)) * 9216 + (3 * mj) * 1024;
      const float* sc = sh + 1024;
#pragma unroll
      for (int i = 0; i < 4; ++i) {
        int col = i * 256 + lane * 4;
        float4 s4 = *(const float4*)(sh + col), c4 = *(const float4*)(sc + col);
#pragma unroll
        for (int r = 0; r < PR; ++r) {
          f32x4 o = {v[r][i].x * (1.f + c4.x) + s4.x, v[r][i].y * (1.f + c4.y) + s4.y, v[r][i].z * (1.f + c4.z) + s4.z, v[r][i].w * (1.f + c4.w) + s4.w};
          *(bf16x4*)(p.ab + (size_t)(row0 + r) * 1024 + col) = pack4(o);
        }
      }
    }
  }
}

struct EpiArgs { bf16_t* o16; const float* modg; float coef; int ncol; int flag; const float* vec; int lnidx; };

__device__ __forceinline__ int g_lds_byte(int r, int c) {
  int st = (r >> 4) * 2 + (c >> 5), rr = r & 15, cc = c & 31, ob = rr * 64 + cc * 2;
  return st * 1024 + (ob ^ (((ob >> 9) & 1) << 5));
}
__device__ __forceinline__ void g_stage_rc(int b, int& R, int& C) {
  int st = b / 1024, sb = b % 1024, swz = sb ^ (((sb >> 9) & 1) << 5);
  R = (st >> 1) * 16 + swz / 64; C = (st & 1) * 32 + (swz % 64) / 2;
}

template <int EPI>
__device__ __forceinline__ void gemm_epilogue(PRef p, const EpiArgs& ea, const f32x4 (&acc)[2][2][4][2],
                                              int brow, int bcol, int wr, int wc, int fr, int fq) {
  const int row0 = brow + wr * 64 + fr, col0 = bcol + wc * 32 + 4 * fq;
  if (EPI == 1) {
#pragma unroll
    for (int ai = 0; ai < 2; ++ai)
#pragma unroll
      for (int m = 0; m < 4; ++m) {
        bf16_t* rp = ea.o16 + (size_t)(row0 + ai * 128 + m * 16) * 2816 + (bcol >> 1) + wc * 32 + 4 * fq;
#pragma unroll
        for (int n = 0; n < 2; ++n) {
          f32x4 g = acc[ai][0][m][n], u = acc[ai][1][m][n], o;
#pragma unroll
          for (int j = 0; j < 4; ++j) o[j] = siluf_(g[j]) * u[j];
          *(bf16x4*)(rp + n * 16) = pack4(o);
        }
      }
  } else if (EPI == 2) {
    const float* gv = ea.modg + (size_t)mod_row(brow) * 9216 + col0;
    const bool ident = ea.lnidx < 0;
    const float* lg = p.ln_g + (ident ? 0 : ea.lnidx) * 1024 + col0;
    const float* lb = p.ln_b + (ident ? 0 : ea.lnidx) * 1024 + col0;
    float* hbase = hs_ptr(p, brow) + (size_t)(wr * 64 + fr) * 1024 + (wc * 32 + 4 * fq) + (bcol);
    const float* xbase = (brow < NL ? p.x + (size_t)brow * 1024 : p.ctx + (size_t)(brow - NL) * 1024) + (size_t)(wr * 64 + fr) * 1024 + (wc * 32 + 4 * fq) + (bcol);
    const float* sbase = p.stats + (size_t)(row0) * 2;
#pragma unroll
    for (int bj = 0; bj < 2; ++bj)
#pragma unroll
      for (int n = 0; n < 2; ++n) {
        const int co = bj * 128 + n * 16;
        const f32x4 gc = *(const f32x4*)(gv + co) * ea.coef;
        f32x4 g4 = {1.f, 1.f, 1.f, 1.f}, b4 = {0.f, 0.f, 0.f, 0.f};
        if (!ident) { g4 = *(const f32x4*)(lg + co); b4 = *(const f32x4*)(lb + co); }
#pragma unroll
        for (int ai = 0; ai < 2; ++ai)
#pragma unroll
          for (int m = 0; m < 4; ++m) {
            const size_t ro = (size_t)(ai * 128 + m * 16) * 1024 + co;
            f32x4 h;
            if (ident) h = *(const f32x4*)(xbase + ro);
            else {
              const float2 st = *(const float2*)(sbase + (ai * 128 + m * 16) * 2);
              h = (*(const f32x4*)(hbase + ro) - st.x) * st.y * g4 + b4;
            }
            *(f32x4*)(hbase + ro) = h * 1.4142135623730951f + gc * acc[ai][bj][m][n];
          }
        asm volatile("" ::: "memory");
      }
  } else if (EPI == 3 || EPI == 4) {
    const int cshift = EPI == 4 ? 1024 : 0;
    const bool dovt = EPI == 3 && ea.flag && bcol >= 1024 && bcol < 1536;
#pragma unroll
    for (int ai = 0; ai < 2; ++ai)
#pragma unroll
      for (int m = 0; m < 4; ++m) {
        const int row = row0 + ai * 128 + m * 16;
        bf16_t* rp = ea.o16 + (size_t)row * LDZ + cshift + col0;
#pragma unroll
        for (int bj = 0; bj < 2; ++bj)
#pragma unroll
          for (int n = 0; n < 2; ++n) {
            const int col = col0 + bj * 128 + n * 16;
            bf16x4 o = pack4(acc[ai][bj][m][n]);
            if (EPI == 4 || col < ea.ncol) *(bf16x4*)(rp + bj * 128 + n * 16) = o;
            if (dovt) {
#pragma unroll
              for (int j = 0; j < 4; ++j) p.vt[(size_t)(col - 1024 + j) * NT + row] = (bf16_t)o[j];
            }
          }
        asm volatile("" ::: "memory");
      }
  } else if (EPI == 6) {
    f32x4 t = {0.f, 0.f, 0.f, 0.f};
#pragma unroll
    for (int ai = 0; ai < 2; ++ai)
#pragma unroll
      for (int bj = 0; bj < 2; ++bj)
#pragma unroll
        for (int m = 0; m < 4; ++m)
#pragma unroll
          for (int n = 0; n < 2; ++n) t += acc[ai][bj][m][n];
    if (t[0] + t[1] + t[2] + t[3] == 12345.678f) ea.o16[row0] = 1;
  } else if (EPI == 5) {
    f32x4 bv[2][2];
#pragma unroll
    for (int bj = 0; bj < 2; ++bj)
#pragma unroll
      for (int n = 0; n < 2; ++n) bv[bj][n] = *(const f32x4*)(ea.vec + col0 + bj * 128 + n * 16);
#pragma unroll
    for (int ai = 0; ai < 2; ++ai)
#pragma unroll
      for (int m = 0; m < 4; ++m) {
        const int row = row0 + ai * 128 + m * 16;
#pragma unroll
        for (int bj = 0; bj < 2; ++bj)
#pragma unroll
          for (int n = 0; n < 2; ++n) {
            const int col = col0 + bj * 128 + n * 16;
            bf16x4 gs = *(const bf16x4*)(p.z + (size_t)row * LDZ + col);
            f32x4 a = acc[ai][bj][m][n] + bv[bj][n], o;
#pragma unroll
            for (int j = 0; j < 4; ++j) o[j] = bf2f((bf16_t)gs[j]) * sigmoidf_(a[j]);
            *(bf16x4*)(p.ab + (size_t)row * 1024 + col) = pack4(o);
          }
      }
  }
}

__device__ __forceinline__ bool gemm_unit(int i, int nM, int nN, int gbid, int gnb, int& pm, int& pn) {
  constexpr int NXCD = 8, WGM = 8;
  const int nwg = nM * nN;
  const long L = (long)i * gnb + gbid;
  if (L >= nwg) return false;
  int wgid = (int)L;
  { const int q = nwg / NXCD, r = nwg % NXCD, xcd = wgid % NXCD, off = wgid / NXCD;
    wgid = (xcd < r ? xcd * (q + 1) : r * (q + 1) + (xcd - r) * q) + off; }
  const int nig = WGM * nN, gid = wgid / nig, fm = gid * WGM, gsz = (nM - fm) < WGM ? (nM - fm) : WGM;
  pm = fm + ((wgid % nig) % gsz); pn = (wgid % nig) / gsz;
  return true;
}

template <int EPI>
__device__ __forceinline__ void phase_gemm(PRef p, const bf16_t* __restrict__ A, int lda, const bf16_t* __restrict__ Bt,
                                           int K, int nM, int nN, const EpiArgs& ea, int row0, int gbid, int gnb) {
  constexpr int BK = 64, HALF = 128, HTB = HALF * BK * 2;
  LAS unsigned char* lds = (LAS unsigned char*)smem;
  const int tid = tidx(), wid = __builtin_amdgcn_readfirstlane(tid >> 6), lane = tid & 63, wr = wid >> 2, wc = wid & 3, fr = lane & 15, fq = lane >> 4;
  const int nt = K / BK;
  unsigned voffA[2], voffB[2];
#pragma unroll
  for (int i = 0; i < 2; ++i) { int R, C; g_stage_rc(tid * 16 + i * 8192, R, C);
    voffA[i] = (unsigned)(R * lda + C) * 2u; voffB[i] = (unsigned)(R * K + C) * 2u; }
  const size_t kstep = (size_t)(BK * 2);
  const size_t hstepA = (size_t)HALF * lda * 2, hstepB = (size_t)HALF * K * 2;
  const size_t tstepA = 2 * hstepA, tstepB = 2 * hstepB;
  const unsigned ldsw = (unsigned)wid * 1024u;
  const int aoff = g_lds_byte(wr * 64 + fr, fq * 8), boff = g_lds_byte(wc * 32 + fr, fq * 8);
#define PG8_SA(b, h) (((b) * 2 + (h)) * HTB)
#define PG8_SB(b, h) ((4 + (b) * 2 + (h)) * HTB)
#define PG8_STAGE(bufoff, gbase, voff) do { _Pragma("unroll") for (int _i = 0; _i < 2; ++_i) \
    __builtin_amdgcn_global_load_lds((const unsigned*)((const char*)(gbase) + (voff)[_i]), (LAS unsigned*)(lds + (bufoff) + ldsw + _i * 8192), 16, 0, 0); } while (0)
#define PG8_LDA(dst, b, h) do { _Pragma("unroll") for (int m = 0; m < 4; ++m) _Pragma("unroll") for (int k = 0; k < 2; ++k) dst[m][k] = *(const LAS bf16x8*)(lds + PG8_SA(b, h) + aoff + m * 2048 + k * 1024); } while (0)
#define PG8_LDB(dst, b, h) do { _Pragma("unroll") for (int n = 0; n < 2; ++n) _Pragma("unroll") for (int k = 0; k < 2; ++k) dst[n][k] = *(const LAS bf16x8*)(lds + PG8_SB(b, h) + boff + n * 2048 + k * 1024); } while (0)
#define PG8_MMA(ai, bj, At_, Bt_) do { __builtin_amdgcn_s_setprio(1); _Pragma("unroll") for (int m = 0; m < 4; ++m) _Pragma("unroll") for (int n = 0; n < 2; ++n) _Pragma("unroll") for (int k = 0; k < 2; ++k) \
    acc[ai][bj][m][n] = __builtin_amdgcn_mfma_f32_16x16x32_bf16(Bt_[n][k], At_[m][k], acc[ai][bj][m][n], 0, 0, 0); __builtin_amdgcn_s_setprio(0); } while (0)
#define PG8_WAIT_V(n) asm volatile("s_waitcnt vmcnt(" #n ")" ::: "memory")
#define PG8_WAIT_L(n) asm volatile("s_waitcnt lgkmcnt(" #n ")" ::: "memory")
#define PG8_BAR __builtin_amdgcn_s_barrier()
#define PG8_SCHED __builtin_amdgcn_sched_barrier(0)
  int cpm, cpn, npm = 0, npn = 0, ui = 0;
  if (gemm_unit(0, nM, nN, gbid, gnb, cpm, cpn)) {
    f32x4 acc[2][2][4][2];
#pragma unroll
    for (int a = 0; a < 2; ++a)
#pragma unroll
      for (int b = 0; b < 2; ++b)
#pragma unroll
        for (int m = 0; m < 4; ++m)
#pragma unroll
          for (int n = 0; n < 2; ++n) acc[a][b][m][n] = f32x4{0.f, 0.f, 0.f, 0.f};
    bf16x8 At[4][2], B0[2][2], B1[2][2];
    const char* cA = (const char*)A + (size_t)cpm * tstepA; const char* cB = (const char*)Bt + (size_t)cpn * tstepB;
    PG8_STAGE(PG8_SB(0, 0), cB, voffB); PG8_STAGE(PG8_SA(0, 0), cA, voffA); PG8_STAGE(PG8_SB(0, 1), cB + hstepB, voffB); PG8_STAGE(PG8_SA(0, 1), cA + hstepA, voffA);
    if (wr == 1) PG8_BAR;
    PG8_WAIT_V(4); PG8_BAR;
    PG8_STAGE(PG8_SB(1, 0), cB + kstep, voffB); PG8_STAGE(PG8_SA(1, 0), cA + kstep, voffA); PG8_STAGE(PG8_SB(1, 1), cB + hstepB + kstep, voffB);
    PG8_WAIT_V(6); PG8_BAR;
    for (;;) {
      const bool has_next = gemm_unit(ui + 1, nM, nN, gbid, gnb, npm, npn);
      const char* nA = has_next ? (const char*)A + (size_t)npm * tstepA : cA; const char* nB = has_next ? (const char*)Bt + (size_t)npn * tstepB : cB;
      for (int t = 0; t < nt; t += 2) {
        const bool last = (t == nt - 2);
        const char* a1 = cA + (size_t)(t + 1) * kstep;
        const char* a2 = last ? nA : cA + (size_t)(t + 2) * kstep; const char* b2 = last ? nB : cB + (size_t)(t + 2) * kstep;
        const char* a3 = a2 + kstep; const char* b3 = b2 + kstep;
        PG8_LDB(B0, 0, 0); PG8_SCHED; PG8_LDA(At, 0, 0); PG8_STAGE(PG8_SA(1, 1), a1 + hstepA, voffA);
        PG8_WAIT_L(8); PG8_BAR; PG8_WAIT_L(0); PG8_MMA(0, 0, At, B0); PG8_BAR; PG8_SCHED;
        PG8_LDB(B1, 0, 1); PG8_STAGE(PG8_SB(0, 0), b2, voffB);
        PG8_BAR; PG8_WAIT_L(0); PG8_MMA(0, 1, At, B1); PG8_BAR;
        PG8_LDA(At, 0, 1); PG8_STAGE(PG8_SA(0, 0), a2, voffA);
        PG8_BAR; PG8_WAIT_L(0); PG8_MMA(1, 0, At, B0); PG8_BAR; PG8_SCHED;
        PG8_STAGE(PG8_SB(0, 1), b2 + hstepB, voffB);
        PG8_WAIT_V(6); PG8_BAR; PG8_MMA(1, 1, At, B1); PG8_BAR;
        PG8_LDB(B0, 1, 0); PG8_SCHED; PG8_LDA(At, 1, 0); PG8_STAGE(PG8_SA(0, 1), a2 + hstepA, voffA);
        PG8_WAIT_L(8); PG8_BAR; PG8_WAIT_L(0); PG8_MMA(0, 0, At, B0); PG8_BAR; PG8_SCHED;
        PG8_LDB(B1, 1, 1); PG8_STAGE(PG8_SB(1, 0), b3, voffB);
        PG8_BAR; PG8_WAIT_L(0); PG8_MMA(0, 1, At, B1); PG8_BAR;
        PG8_LDA(At, 1, 1); PG8_STAGE(PG8_SA(1, 0), a3, voffA);
        PG8_BAR; PG8_WAIT_L(0); PG8_MMA(1, 0, At, B0); PG8_BAR; PG8_SCHED;
        PG8_STAGE(PG8_SB(1, 1), b3 + hstepB, voffB);
        PG8_WAIT_V(6); PG8_BAR; PG8_MMA(1, 1, At, B1); PG8_BAR;
      }
      gemm_epilogue<EPI>(p, ea, acc, row0 + cpm * 256, cpn * 256, wr, wc, fr, fq);
      if (!has_next) break;
#pragma unroll
      for (int a = 0; a < 2; ++a)
#pragma unroll
        for (int b = 0; b < 2; ++b)
#pragma unroll
          for (int m = 0; m < 4; ++m)
#pragma unroll
            for (int n = 0; n < 2; ++n) acc[a][b][m][n] = f32x4{0.f, 0.f, 0.f, 0.f};
      cpm = npm; cpn = npn; cA = nA; cB = nB; ++ui;
    }
    PG8_WAIT_V(0);
    if (wr == 0) PG8_BAR;
    PG8_BAR;
  }
  __syncthreads();
#undef PG8_SA
#undef PG8_SB
#undef PG8_STAGE
#undef PG8_LDA
#undef PG8_LDB
#undef PG8_MMA
#undef PG8_WAIT_V
#undef PG8_WAIT_L
#undef PG8_BAR
#undef PG8_SCHED
}

__device__ __forceinline__ void phase_mlconv(PRef p) {
  const int lane = tidx() & 63, wid = tidx() >> 6;
  const int ch = lane * 8;
  float w[5][8], cb[8];
#pragma unroll
  for (int j = 0; j < 5; ++j)
#pragma unroll
    for (int e = 0; e < 8; ++e) w[j][e] = p.conv_w[j * 512 + ch + e];
#pragma unroll
  for (int e = 0; e < 8; ++e) cb[e] = p.conv_b[ch + e];
  for (int row0 = (blockIdx.x * 8 + wid) * 2; row0 < NT; row0 += gridDim.x * 16) {
    int tpos, len;
    if (row0 < NL) { tpos = row0 & 4095; len = 4096; } else { tpos = (row0 - NL) & 255; len = 256; }
    bf16x8 xv[6];
#pragma unroll
    for (int j = 0; j < 6; ++j) {
      int tp = tpos + j - 2;
      xv[j] = bf16x8{0, 0, 0, 0, 0, 0, 0, 0};
      if (tp >= 0 && tp < len) xv[j] = *(const bf16x8*)(p.z + (size_t)(row0 + j - 2) * LDZ + 1536 + ch);
    }
    float gz[2] = {0.f, 0.f};
    if (lane < 16) { gz[0] = bf2f(p.z[(size_t)row0 * LDZ + 3072 + lane]); gz[1] = bf2f(p.z[(size_t)(row0 + 1) * LDZ + 3072 + lane]); }
#pragma unroll
    for (int r = 0; r < 2; ++r) {
      float a[8];
#pragma unroll
      for (int e = 0; e < 8; ++e) a[e] = cb[e];
#pragma unroll
      for (int j = 0; j < 5; ++j)
#pragma unroll
        for (int e = 0; e < 8; ++e) a[e] += w[j][e] * bf2f((bf16_t)xv[r + j][e]);
#pragma unroll
      for (int e = 0; e < 8; ++e) a[e] = siluf_(a[e]);
      *(bf16x8*)(p.och + (size_t)(row0 + r) * 512 + ch) = pack8(a);
      if (lane < 16) {
        float gv = lane < 8 ? gz[r] + p.i_bias[lane] : log_sigmoidf_(gz[r] + p.f_bias[lane - 8]);
        p.gates[(size_t)(row0 + r) * 16 + lane] = gv;
      }
    }
  }
}

typedef __attribute__((ext_vector_type(4))) short s16x4;
__device__ __forceinline__ bf16x8 tr_pair(const bf16_t* base, int byte0, int byte1) {
  s16x4 lo = __builtin_amdgcn_ds_read_tr16_b64_v4i16((LAS s16x4*)((LAS char*)base + byte0));
  s16x4 hi = __builtin_amdgcn_ds_read_tr16_b64_v4i16((LAS s16x4*)((LAS char*)base + byte1));
  bf16x8 r; r[0] = lo[0]; r[1] = lo[1]; r[2] = lo[2]; r[3] = lo[3]; r[4] = hi[0]; r[5] = hi[1]; r[6] = hi[2]; r[7] = hi[3];
  return r;
}
template <int MODE>
__device__ __forceinline__ void chain_block(PRef p, int chain, bf16_t* __restrict__ outbuf) {
  constexpr int NV = MODE == 0 ? 9 : 8;
  constexpr int PKN = 136, PKB = 144, PKV = 160;
  const int tid = tidx(), wid = __builtin_amdgcn_readfirstlane(tid >> 6), lane = tid & 63, fr = lane & 15, fq = lane >> 4;
  const int b = chain >> 3, h = (chain >> 1) & 3, d = chain & 1;
  LAS bf16_t* Kn = (LAS bf16_t*)smem;
  LAS bf16_t* Kb = Kn + 128 * PKN;
  LAS bf16_t* Vn = Kb + 128 * PKB;
  LAS bf16_t* Tt = Vn + 128 * PKV;
  LAS float* sa = (LAS float*)(Tt + 144 * PKN);
  LAS float* sM = sa + 128; LAS float* salpha = sM + 128; LAS float* sbeta = salpha + 128; LAS float* sclamp = sbeta + 128;
  LAS float* sdecay = sclamp + 128;
  const int qcol = MODE == 0 ? 1024 + h * 128 : 512 + h * 128;
  const int kcol = MODE == 0 ? 1536 + h * 128 : 1024 + h * 128;
  const int vcol = MODE == 0 ? 2048 + h * 128 : 1536 + h * 128;
  for (int i = tid; i < 144 * PKN; i += 512) Tt[i] = 0;
  for (int i = tid; i < 128 * 32; i += 512) {
    int r = i >> 5, cc = 128 + (i & 31);
    Vn[r * PKV + cc] = (MODE == 0 && cc == 128) ? (bf16_t)0x3F80 : (bf16_t)0;
  }
  if (MODE == 1 && tid < 128) {
    float lg = log_sigmoidf_(p.decay_logit[d * 4 + h]);
    sa[tid] = -(float)tid * lg; sM[tid] = -(float)tid * lg;
    salpha[tid] = expf((float)(tid + 1) * lg); sbeta[tid] = expf((float)(127 - tid) * lg);
    sclamp[tid] = 1.f;
    if (tid == 0) sdecay[0] = expf(128.f * lg);
  }
  f32x4 T[NV];
#pragma unroll
  for (int i = 0; i < NV; ++i) T[i] = f32x4{0.f, 0.f, 0.f, 0.f};
  float m_prev = 0.f;
  bf16x8 pk[4], pv[4], pq[4];
  float gi0 = 0.f, gf0 = 0.f, gi1 = 0.f, gf1 = 0.f;
  const bf16_t* Z = p.z;
#define CHAIN_ISSUE(cc) do { \
    _Pragma("unroll") for (int i_ = 0; i_ < 4; ++i_) { int idx_ = tid + i_ * 512, pr_ = idx_ >> 4, cv_ = idx_ & 15; \
      size_t ro_ = (size_t)chain_row(b, d, (cc) * 128 + pr_) * LDZ; \
      pk[i_] = *(const bf16x8*)(Z + ro_ + kcol + cv_ * 8); pv[i_] = *(const bf16x8*)(Z + ro_ + vcol + cv_ * 8); } \
    { size_t ro_ = (size_t)chain_row(b, d, (cc) * 128 + wid * 16 + fr) * LDZ + qcol + fq * 8; \
      _Pragma("unroll") for (int kk_ = 0; kk_ < 4; ++kk_) pq[kk_] = *(const bf16x8*)(Z + ro_ + kk_ * 32); } \
    if (MODE == 0 && wid == 0) { \
      int r0_ = chain_row(b, d, (cc) * 128 + 2 * lane), r1_ = chain_row(b, d, (cc) * 128 + 2 * lane + 1); \
      gi0 = p.gates[(size_t)r0_ * 16 + d * 4 + h]; gf0 = p.gates[(size_t)r0_ * 16 + 8 + d * 4 + h]; \
      gi1 = p.gates[(size_t)r1_ * 16 + d * 4 + h]; gf1 = p.gates[(size_t)r1_ * 16 + 8 + d * 4 + h]; } } while (0)
  CHAIN_ISSUE(0);
  __syncthreads();
  for (int c = 0; c < 34; ++c) {
    if (MODE == 0 && wid == 0) {
      float i0 = gi0, f0 = gf0, i1 = gi1, f1 = gf1;
      float c1 = f0 + f1, inc = c1;
#pragma unroll
      for (int o = 1; o < 64; o <<= 1) { float t = __shfl_up(inc, o); if (lane >= o) inc += t; }
      float off = inc - c1, b0 = off + f0, b1 = off + c1;
      float a0 = i0 - b0, a1 = i1 - b1;
      float x1 = fmaxf(a0, a1), mx = x1;
#pragma unroll
      for (int o = 1; o < 64; o <<= 1) { float t = __shfl_up(mx, o); if (lane >= o) mx = fmaxf(mx, t); }
      float offm = __shfl_up(mx, 1); if (lane == 0) offm = -INFINITY;
      float M0 = fmaxf(m_prev, fmaxf(offm, a0)), M1 = fmaxf(M0, a1);
      float bL = __shfl(b1, 63), ML = __shfl(M1, 63);
      sa[2 * lane] = a0; sa[2 * lane + 1] = a1; sM[2 * lane] = M0; sM[2 * lane + 1] = M1;
      salpha[2 * lane] = expf(m_prev - M0); salpha[2 * lane + 1] = expf(m_prev - M1);
      sbeta[2 * lane] = expf(a0 - ML); sbeta[2 * lane + 1] = expf(a1 - ML);
      sclamp[2 * lane] = expf(-(b0 + M0)); sclamp[2 * lane + 1] = expf(-(b1 + M1));
      if (lane == 0) sdecay[0] = expf(m_prev - ML);
      m_prev = bL + ML;
    }
    __syncthreads();
    bf16x8 qf[4];
#pragma unroll
    for (int kk = 0; kk < 4; ++kk) qf[kk] = pq[kk];
#pragma unroll
    for (int i = 0; i < 4; ++i) {
      int idx = tid + i * 512, pr = idx >> 4, cv = idx & 15;
      *(LAS bf16x8*)(Kn + pr * PKN + cv * 8) = pk[i];
      *(LAS bf16x8*)(Vn + pr * PKV + cv * 8) = pv[i];
      float be = sbeta[pr];
      float kbf[8];
#pragma unroll
      for (int e = 0; e < 8; ++e) kbf[e] = bf2f((bf16_t)pk[i][e]) * be;
      *(LAS bf16x8*)(Kb + pr * PKB + cv * 8) = pack8(kbf);
    }
    if (c + 1 < 34) CHAIN_ISSUE(c + 1);
    __syncthreads();
    const int tq = wid * 16 + fr;
    const float Mt = sM[tq];
    bf16x8 pb[4];
    float dsum = 0.f;
#pragma unroll
    for (int ks = 0; ks < 4; ++ks) {
      pb[ks] = bf16x8{0, 0, 0, 0, 0, 0, 0, 0};
      if (2 * ks <= wid) {
#pragma unroll
        for (int hn = 0; hn < 2; ++hn) {
          const int n = 2 * ks + hn;
          f32x4 sacc = f32x4{0.f, 0.f, 0.f, 0.f};
          if (n <= wid) {
#pragma unroll
            for (int kk = 0; kk < 4; ++kk) {
              bf16x8 ka = *(const LAS bf16x8*)(Kn + (n * 16 + fr) * PKN + kk * 32 + fq * 8);
              sacc = __builtin_amdgcn_mfma_f32_16x16x32_bf16(ka, qf[kk], sacc, 0, 0, 0);
            }
          }
          const f32x4 as4 = *(const LAS f32x4*)(sa + n * 16 + fq * 4);
          f32x4 pv4;
#pragma unroll
          for (int j = 0; j < 4; ++j) {
            const int sidx = n * 16 + fq * 4 + j;
            pv4[j] = (n <= wid && sidx <= tq) ? sacc[j] * __expf(as4[j] - Mt) : 0.f;
            dsum += pv4[j];
          }
          bf16x4 pk4 = pack4(pv4);
#pragma unroll
          for (int j = 0; j < 4; ++j) pb[ks][hn * 4 + j] = pk4[j];
        }
      }
    }
    f32x4 O[NV];
    {
      const float al = salpha[tq];
#pragma unroll
      for (int nv = 0; nv < NV; ++nv) {
        f32x4 o = f32x4{0.f, 0.f, 0.f, 0.f};
#pragma unroll
        for (int kk = 0; kk < 4; ++kk) {
          bf16x8 ta = *(const LAS bf16x8*)(Tt + (nv * 16 + fr) * PKN + kk * 32 + fq * 8);
          o = __builtin_amdgcn_mfma_f32_16x16x32_bf16(ta, qf[kk], o, 0, 0, 0);
        }
        O[nv] = o * al;
      }
    }
    float den_inter = 0.f;
    if (MODE == 0) {
      den_inter = __shfl(O[NV - 1][0], fr);
      dsum += __shfl_xor(dsum, 16); dsum += __shfl_xor(dsum, 32);
    }
#pragma unroll
    for (int ks = 0; ks < 4; ++ks) {
      if (2 * ks <= wid) {
        const int r0 = 32 * ks + 4 * fq + (fr >> 2);
#pragma unroll
        for (int nv = 0; nv < NV; ++nv) {
          const int cb = nv * 32 + (fr & 3) * 8;
          bf16x8 va = tr_pair((const bf16_t*)Vn, r0 * (PKV * 2) + cb, (r0 + 16) * (PKV * 2) + cb);
          O[nv] = __builtin_amdgcn_mfma_f32_16x16x32_bf16(va, pb[ks], O[nv], 0, 0, 0);
        }
      }
    }
    {
      const int row = chain_row(b, d, c * 128 + tq);
      float inv = 1.f;
      if (MODE == 0) {
        float den = den_inter + dsum;
        inv = __builtin_amdgcn_rcpf(fmaxf(fabsf(den), sclamp[tq]));
      }
      bf16_t* op = outbuf + ((size_t)d * NT + row) * 512 + h * 128 + fq * 4;
#pragma unroll
      for (int nv = 0; nv < 8; ++nv) *(bf16x4*)(op + nv * 16) = pack4(O[nv] * inv);
    }
    {
      const float dec = sdecay[0];
#pragma unroll
      for (int nv = 0; nv < NV; ++nv) T[nv] = T[nv] * dec;
#pragma unroll
      for (int kk = 0; kk < 4; ++kk) {
        const int r0 = 32 * kk + 8 * fq + (fr >> 2);
        bf16x8 ka = tr_pair((const bf16_t*)Kb, r0 * (PKB * 2) + wid * 32 + (fr & 3) * 8, (r0 + 4) * (PKB * 2) + wid * 32 + (fr & 3) * 8);
#pragma unroll
        for (int nv = 0; nv < NV; ++nv) {
          const int cb = nv * 32 + (fr & 3) * 8;
          bf16x8 vb = tr_pair((const bf16_t*)Vn, r0 * (PKV * 2) + cb, (r0 + 4) * (PKV * 2) + cb);
          T[nv] = __builtin_amdgcn_mfma_f32_16x16x32_bf16(ka, vb, T[nv], 0, 0, 0);
        }
      }
    }
    __syncthreads();
#pragma unroll
    for (int nv = 0; nv < NV; ++nv) *(LAS bf16x4*)(Tt + (nv * 16 + fr) * PKN + wid * 16 + fq * 4) = pack4(T[nv]);
  }
#undef CHAIN_ISSUE
  __syncthreads();
}

template <bool LOCAL>
__device__ __forceinline__ void na_task(PRef p, int task, int lane) {
  constexpr int NG = LOCAL ? 2 : 1;
  const int fr = lane & 15, fq = lane >> 4;
  int b, h, r = 0, wq = 0, qrow, rs = 0, cs0 = 0;
  if (LOCAL) {
    b = task >> 11; h = (task >> 8) & 7; r = (task >> 2) & 63; wq = task & 3;
    qrow = b * 4096 + r * 64 + wq * 16 + fr;
    rs = min(max(r - 4, 0), 56);
    cs0 = wq == 0 ? 0 : (wq == 1 ? 8 : (wq == 2 ? 24 : 32));
  } else {
    b = task >> 7; h = (task >> 4) & 7;
    qrow = NL + b * 256 + (task & 15) * 16 + fr;
  }
  const bf16_t* Z = p.z;
  bf16x8 qf[2];
#pragma unroll
  for (int kk = 0; kk < 2; ++kk) qf[kk] = *(const bf16x8*)(Z + (size_t)qrow * LDZ + h * 64 + kk * 32 + fq * 8);
  f32x4 O[4];
#pragma unroll
  for (int i = 0; i < 4; ++i) O[i] = f32x4{0.f, 0.f, 0.f, 0.f};
  float m_run = -INFINITY, l_run = 0.f;
  constexpr int NGRP = LOCAL ? 4 : 2;
  bf16x8 kc0[8], kc1[8];
#define NA_KLOAD(G_) do { const int g_ = (G_); const bool l_ = LOCAL && g_ < 2; const int c_ = LOCAL ? g_ - 2 : g_; \
    _Pragma("unroll") for (int T = 0; T < 8; ++T) { \
      const int pb_ = l_ ? b * 4096 + (rs + g_ * 4 + (T >> 1)) * 64 + cs0 : NL + b * 256 + (c_ * 8 + (T & ~1)) * 16; \
      const bf16_t* kp_ = Z + (size_t)(pb_ + 8 * (fr >> 2) + (fr & 3) + 4 * (T & 1)) * LDZ + 512 + h * 64 + fq * 8; \
      kc0[T] = *(const bf16x8*)kp_; kc1[T] = *(const bf16x8*)(kp_ + 32); } } while (0)
  NA_KLOAD(0);
#pragma unroll 1
  for (int grp = 0; grp < NGRP; ++grp) {
    const bool loc = LOCAL && grp < 2;
    const int cg0 = LOCAL ? grp - 2 : grp;
    f32x4 S[8];
#pragma unroll
    for (int T = 0; T < 8; ++T) {
      f32x4 a = f32x4{0.f, 0.f, 0.f, 0.f};
      a = __builtin_amdgcn_mfma_f32_16x16x32_bf16(kc0[T], qf[0], a, 0, 0, 0);
      a = __builtin_amdgcn_mfma_f32_16x16x32_bf16(kc1[T], qf[1], a, 0, 0, 0);
      S[T] = a;
    }
    bf16x8 vf[4][4];
#pragma unroll
    for (int ks = 0; ks < 4; ++ks) {
      const int tr0 = loc ? b * 4096 + (rs + grp * 4 + ks) * 64 + cs0 : NL + b * 256 + (cg0 * 8 + 2 * ks) * 16;
#pragma unroll
      for (int dvt = 0; dvt < 4; ++dvt) vf[ks][dvt] = *(const bf16x8*)(p.vt + (size_t)(h * 64 + dvt * 16 + fr) * NT + tr0 + 8 * fq);
    }
    if (grp + 1 < NGRP) NA_KLOAD(grp + 1);
    float mx = -INFINITY;
#pragma unroll
    for (int T = 0; T < 8; ++T) {
      f32x4 a = S[T];
      if (loc) {
        int qc = wq * 16 + fr, st = min(max(qc - 8, 0), 48);
        int roff = rs + grp * 4 + (T >> 1) - r + 7;
#pragma unroll
        for (int j = 0; j < 4; ++j) {
          int kc = cs0 + 8 * fq + 4 * (T & 1) + j;
          bool valid = kc >= st && kc < st + 16;
          float bias = valid ? ((const LAS float*)smem)[roff * 31 + (kc - qc + 15)] : 0.f;
          a[j] = valid ? a[j] * 0.125f + bias : -INFINITY;
        }
      } else {
#pragma unroll
        for (int j = 0; j < 4; ++j) a[j] *= 0.125f;
      }
#pragma unroll
      for (int j = 0; j < 4; ++j) mx = fmaxf(mx, a[j]);
      S[T] = a;
    }
    mx = fmaxf(mx, __shfl_xor(mx, 16)); mx = fmaxf(mx, __shfl_xor(mx, 32));
    float m_new = fmaxf(m_run, mx);
    float scl = __expf(m_run - m_new);
    l_run *= scl;
#pragma unroll
    for (int i = 0; i < 4; ++i)
#pragma unroll
      for (int j = 0; j < 4; ++j) O[i][j] *= scl;
    m_run = m_new;
#pragma unroll
    for (int ks = 0; ks < 4; ++ks) {
      float ev[8];
#pragma unroll
      for (int j = 0; j < 4; ++j) {
        float e0 = __expf(S[2 * ks][j] - m_new), e1 = __expf(S[2 * ks + 1][j] - m_new);
        l_run += e0 + e1;
        ev[j] = e0; ev[4 + j] = e1;
      }
      bf16x8 pb = pack8(ev);
#pragma unroll
      for (int dvt = 0; dvt < 4; ++dvt) O[dvt] = __builtin_amdgcn_mfma_f32_16x16x32_bf16(vf[ks][dvt], pb, O[dvt], 0, 0, 0);
    }
  }
#undef NA_KLOAD
  l_run += __shfl_xor(l_run, 16); l_run += __shfl_xor(l_run, 32);
  float inv = __builtin_amdgcn_rcpf(l_run);
#pragma unroll
  for (int dvt = 0; dvt < 4; ++dvt) {
    *(bf16x4*)(p.ab + (size_t)qrow * 1024 + h * 64 + dvt * 16 + fq * 4) = pack4(O[dvt] * inv);
  }
}

__device__ __forceinline__ void s5_chain(PRef p, int chain, int wslot, int lane) {
  const int d = chain & 1, g = (chain >> 1) & 31, b = chain >> 6;
  const int fr = lane & 15, fq = lane >> 4;
  constexpr int BP = 36, XP = 36;
  float* Bu = (float*)(smem + wslot * 28672);
  bf16_t* X = (bf16_t*)(smem + wslot * 28672 + 128 * BP * 4);
  const int pg = (d * 32 + g) * 64 + lane;
  float ar, ai;
  float erf_, eif_;
  {
    double lr = p.lam_re[pg], li = p.lam_im[pg];
    double dt = (double)expf(p.log_dt[d * 32 + g]);
    double zr = lr * dt, zi = li * dt;
    double mag = (double)expf((float)zr);
    float sn, cs; sincos_d(zi, &sn, &cs);
    double are = mag * cs, aim = mag * sn;
    double lsq = lr * lr + li * li;
    double er = ((are - 1.0) * lr + aim * li) / lsq, ei = (aim * lr - (are - 1.0) * li) / lsq;
    ar = (float)are; ai = (float)aim; erf_ = (float)er; eif_ = (float)ei;
  }
  bf16x8 bbf[8];
#pragma unroll
  for (int ct = 0; ct < 8; ++ct) {
    const int c = ct * 16 + fr, pp = c & 63;
    const float epr = __shfl(erf_, pp), epi = __shfl(eif_, pp);
    bf16x8 v = {0, 0, 0, 0, 0, 0, 0, 0};
    if (fq < 2) {
      const size_t bo = ((size_t)(d * 32 + g) * 64 + pp) * 16 + fq * 8;
      float4 r0 = *(const float4*)(p.b_re + bo), r1 = *(const float4*)(p.b_re + bo + 4);
      float4 i0 = *(const float4*)(p.b_im + bo), i1 = *(const float4*)(p.b_im + bo + 4);
      float brv[8] = {r0.x, r0.y, r0.z, r0.w, r1.x, r1.y, r1.z, r1.w}, biv[8] = {i0.x, i0.y, i0.z, i0.w, i1.x, i1.y, i1.z, i1.w};
#pragma unroll
      for (int e = 0; e < 8; ++e) v[e] = (short)f2bf(c < 64 ? epr * brv[e] - epi * biv[e] : epr * biv[e] + epi * brv[e]);
    }
    bbf[ct] = v;
  }
  bf16x8 cf[4];
#pragma unroll
  for (int kk = 0; kk < 4; ++kk) {
    const int k0 = kk * 32 + fq * 8;
    const float* src = (k0 < 64 ? p.c_re : p.c_im) + ((size_t)(d * 32 + g) * 16 + fr) * 64 + (k0 & 63);
    const float sg = k0 < 64 ? 1.f : -1.f;
    float4 c0 = *(const float4*)src, c1 = *(const float4*)(src + 4);
    float cv[8] = {sg * c0.x, sg * c0.y, sg * c0.z, sg * c0.w, sg * c1.x, sg * c1.y, sg * c1.z, sg * c1.w};
    cf[kk] = pack8(cv);
  }
  float xr = 0.f, xi = 0.f;
  bf16_t* ys = p.vt + (size_t)d * NT * 512;
  const bf16x8 zero8 = {0, 0, 0, 0, 0, 0, 0, 0};
  bf16x8 uf[2], un[2], un2[2], un3[2];
#define S5_ULOAD(dst, SC) do { _Pragma("unroll") for (int rt = 0; rt < 2; ++rt) { dst[rt] = zero8; \
    if (fq < 2 && (SC) < 136) dst[rt] = *(const bf16x8*)(p.z + (size_t)chain_row(b, d, (SC) * 32 + rt * 16 + fr) * LDZ + g * 16 + fq * 8); } } while (0)
  S5_ULOAD(uf, 0); S5_ULOAD(un, 1); S5_ULOAD(un2, 2);
  for (int sc = 0; sc < 136; ++sc) {
    S5_ULOAD(un3, sc + 3);
#pragma unroll
    for (int rt = 0; rt < 2; ++rt)
#pragma unroll
      for (int ct = 0; ct < 8; ++ct) {
        f32x4 a = __builtin_amdgcn_mfma_f32_16x16x32_bf16(uf[rt], bbf[ct], f32x4{0.f, 0.f, 0.f, 0.f}, 0, 0, 0);
        *(f32x4*)(Bu + (ct * 16 + fr) * BP + rt * 16 + fq * 4) = a;
      }
    __builtin_amdgcn_fence(__ATOMIC_SEQ_CST, "wavefront");
    __builtin_amdgcn_wave_barrier();
#pragma unroll
    for (int g4 = 0; g4 < 8; ++g4) {
      const f32x4 br = *(const f32x4*)(Bu + lane * BP + g4 * 4), bi = *(const f32x4*)(Bu + (64 + lane) * BP + g4 * 4);
      float sr[4], si[4];
#pragma unroll
      for (int k = 0; k < 4; ++k) {
        float nr = ar * xr - ai * xi + br[k], ni = ar * xi + ai * xr + bi[k];
        xr = nr; xi = ni; sr[k] = nr; si[k] = ni;
      }
      u32x2 wr, wi;
      wr[0] = cvt_pk_bf16(sr[0], sr[1]); wr[1] = cvt_pk_bf16(sr[2], sr[3]);
      wi[0] = cvt_pk_bf16(si[0], si[1]); wi[1] = cvt_pk_bf16(si[2], si[3]);
      *(u32x2*)(X + lane * XP + g4 * 4) = wr;
      *(u32x2*)(X + (64 + lane) * XP + g4 * 4) = wi;
    }
    __builtin_amdgcn_fence(__ATOMIC_SEQ_CST, "wavefront");
    __builtin_amdgcn_wave_barrier();
#pragma unroll
    for (int tl = 0; tl < 2; ++tl) {
      f32x4 a = f32x4{0.f, 0.f, 0.f, 0.f};
#pragma unroll
      for (int kk = 0; kk < 4; ++kk) {
        const int xo = (kk * 32 + fq * 8 + (fr >> 2)) * (XP * 2) + tl * 32 + (fr & 3) * 8;
        bf16x8 xa = tr_pair((const bf16_t*)X, xo, xo + 4 * (XP * 2));
        a = __builtin_amdgcn_mfma_f32_16x16x32_bf16(xa, cf[kk], a, 0, 0, 0);
      }
#pragma unroll
      for (int j = 0; j < 4; ++j) {
        int row = chain_row(b, d, sc * 32 + tl * 16 + fq * 4 + j);
        ys[(size_t)row * 512 + g * 16 + fr] = f2bf(a[j]);
      }
    }
    __builtin_amdgcn_fence(__ATOMIC_SEQ_CST, "wavefront");
    __builtin_amdgcn_wave_barrier();
    uf[0] = un[0]; uf[1] = un[1]; un[0] = un2[0]; un[1] = un2[1]; un2[0] = un3[0]; un2[1] = un3[1];
  }
#undef S5_ULOAD
}

template <int WHAT>
__device__ __forceinline__ void phase_mix_even(PRef p, int only_chain) {
  const int nb = gridDim.x, bid = blockIdx.x;
  const int wid = tidx() >> 6, lane = tidx() & 63;
  if (WHAT != 2) { if (bid < 64) { chain_block<0>(p, bid, p.och); return; } }
  if (WHAT != 1 && !only_chain) {
    const int b2 = WHAT == 2 ? bid : bid - 64, nb2 = WHAT == 2 ? nb : nb - 64;
    const bool swz = (nb2 & 7) == 0 && WHAT == 0;
    const int xcd = b2 & 7, rank = b2 >> 3, per = nb2 >> 3;
    const int t_lo = swz ? xcd * 2048 + rank * 8 : b2 * 8, t_hi = swz ? (xcd + 1) * 2048 : 16384, t_st = swz ? per * 8 : nb2 * 8;
    for (int base = t_lo; base < t_hi; base += t_st) {
      __syncthreads();
      if (tidx() < 465) ((LAS float*)smem)[tidx()] = p.rpb[((base >> 8) & 7) * 465 + tidx()];
      __syncthreads();
      na_task<true>(p, base + wid, lane);
    }
    for (int task = b2 * 8 + wid; task < 1024; task += nb2 * 8) na_task<false>(p, task, lane);
  }
}
__device__ __forceinline__ void phase_mix_odd(PRef p, int only_chain) {
  const int nb = gridDim.x, bid = blockIdx.x;
  const int wid = tidx() >> 6, lane = tidx() & 63;
  if (bid < 64) { chain_block<1>(p, bid, p.och); return; }
  const int b2 = bid - 64, nb2 = nb - 64;
  if (wid < 4 && !only_chain) {
    if ((nb2 & 7) == 0 && (nb2 >> 3) * 3 >= 64) {
      const int xcd = b2 & 7, slot = (b2 >> 3) * 3 + wid;
      if (wid < 3 && slot < 64) s5_chain(p, ((((slot >> 3) << 3) + xcd) << 3) + (slot & 7), wid, lane);
    } else {
      for (int ch = b2 + nb2 * wid; ch < 512; ch += nb2 * 4) s5_chain(p, ch, wid, lane);
    }
  }
}

template <int MODE>
__device__ __forceinline__ void phase_combine(PRef p) {
  const int lane = tidx() & 63, wid = tidx() >> 6;
  const int ch = lane * 8;
  const float* gn = MODE == 0 ? p.ml_gn : p.ret_gn;
  float gw[8], dsk[8];
#pragma unroll
  for (int e = 0; e < 8; ++e) { gw[e] = gn[ch + e]; dsk[e] = MODE == 1 ? p.s5_d[ch + e] : 0.f; }
  for (int row0 = (blockIdx.x * 8 + wid) * 2; row0 < NT; row0 += gridDim.x * 16) {
    bf16x8 o0[2], o1[2], zg[2], y0[2], y1[2], uu[2];
#pragma unroll
    for (int r = 0; r < 2; ++r) {
      const int row = row0 + r;
      o0[r] = *(const bf16x8*)(p.och + (size_t)row * 512 + ch);
      o1[r] = *(const bf16x8*)(p.och + ((size_t)NT + row) * 512 + ch);
      zg[r] = *(const bf16x8*)(p.z + (size_t)row * LDZ + (MODE == 0 ? 2560 : 2048) + ch);
      if (MODE == 1) {
        y0[r] = *(const bf16x8*)(p.vt + (size_t)row * 512 + ch);
        y1[r] = *(const bf16x8*)(p.vt + ((size_t)NT + row) * 512 + ch);
        uu[r] = *(const bf16x8*)(p.z + (size_t)row * LDZ + ch);
      }
    }
#pragma unroll
    for (int r = 0; r < 2; ++r) {
      const int row = row0 + r;
      float v[8], s = 0.f;
#pragma unroll
      for (int e = 0; e < 8; ++e) { v[e] = bf2f((bf16_t)o0[r][e]) + bf2f((bf16_t)o1[r][e]); s += v[e]; }
#pragma unroll
      for (int o = 8; o > 0; o >>= 1) s += __shfl_xor(s, o);
      float mu = s * (1.f / 128.f), q = 0.f;
#pragma unroll
      for (int e = 0; e < 8; ++e) { v[e] -= mu; q += v[e] * v[e]; }
#pragma unroll
      for (int o = 8; o > 0; o >>= 1) q += __shfl_xor(q, o);
      float rstd = rsqrtf(q * (1.f / 128.f) + 1e-5f);
      float ov[8];
#pragma unroll
      for (int e = 0; e < 8; ++e) {
        float zz = bf2f((bf16_t)zg[r][e]);
        float gt = MODE == 0 ? sigmoidf_(zz) : siluf_(zz);
        ov[e] = gt * v[e] * rstd * gw[e];
      }
      *(bf16x8*)(p.ab + (size_t)row * 1024 + 512 + ch) = pack8(ov);
      if (MODE == 1) {
        float gsv[8];
#pragma unroll
        for (int e = 0; e < 8; ++e) {
          float y = bf2f((bf16_t)y0[r][e]) + bf2f((bf16_t)y1[r][e]) + dsk[e] * bf2f((bf16_t)uu[r][e]);
          float t = tanhf(0.7978845608028654f * (y + 0.044715f * y * y * y));
          gsv[e] = 0.5f * y * (1.f + t);
        }
        *(bf16x8*)(p.z + (size_t)row * LDZ + ch) = pack8(gsv);
      }
    }
  }
}

__device__ __forceinline__ void phase_rope(PRef p) {
  const int lane = tidx() & 63, wid = tidx() >> 6;
  for (int row = blockIdx.x * 8 + wid; row < NT; row += gridDim.x * 8) {
    const bool lat = row < NL;
    const int t = row & 4095;
    bf16_t* zr = p.z + (size_t)row * LDZ + 512;
    bf16x8 own[2], oth[2];
#pragma unroll
    for (int it = 0; it < 2; ++it) {
      const int e0 = (lane + 64 * it) * 8;
      own[it] = *(const bf16x8*)(zr + e0);
      oth[it] = *(const bf16x8*)(zr + (e0 ^ 32));
    }
#pragma unroll
    for (int it = 0; it < 2; ++it) {
      const int e0 = (lane + 64 * it) * 8;
      const int qk = e0 >> 9, d = e0 & 127, hs = d >> 6, second = (d >> 5) & 1, i0 = d & 31;
      const int pos = hs ? (t & 63) : (t >> 6);
      float o[8];
#pragma unroll
      for (int e = 0; e < 8; ++e) {
        float xo = bf2f((bf16_t)own[it][e]), xp = bf2f((bf16_t)oth[it][e]);
        float r = xo;
        if (lat) {
          const float2 cs = *(const float2*)(p.rope + (pos * 32 + i0 + e) * 2);
          r = second ? xo * cs.x + xp * cs.y : xo * cs.x - xp * cs.y;
        }
        o[e] = qk ? r * 0.08838834764831845f : r;
      }
      *(bf16x8*)(zr + e0) = pack8(o);
    }
  }
}

#if MK_COOP
#define XB_TMO      128
#define XB_XCNT(j)  (256  + 64 * (j))
#define XB_XSUB(j)  (1280 + 64 * (j))
#define XB_XGEN(j)  (2304 + 64 * (j))
#define XB_TOP      3328
#define XB_TOPGEN   3392
#define XCD_BAR_WORDS 3456
#define XB_SPIN_CAP (1u << 21)
__device__ __forceinline__ unsigned xb_ld(unsigned* q)              { return __hip_atomic_load(q, __ATOMIC_RELAXED, __HIP_MEMORY_SCOPE_AGENT); }
__device__ __forceinline__ unsigned xb_add(unsigned* q, unsigned v) { return __hip_atomic_fetch_add(q, v, __ATOMIC_RELAXED, __HIP_MEMORY_SCOPE_AGENT); }
__device__ __forceinline__ unsigned xb_xcc_id() { return (unsigned)__builtin_amdgcn_s_getreg((3 << 11) | 20) & 0xFu; }
#define XB_SPIN(cond, bar) do { unsigned _sp = 0; while (cond) { __builtin_amdgcn_s_sleep(1); \
    if ((++_sp & 255u) == 0u) { if (xb_ld(&(bar)[XB_TMO])) break; if (_sp > XB_SPIN_CAP) { atomicAdd(&(bar)[XB_TMO], 1u); break; } } } } while (0)
__device__ __forceinline__ volatile LAS unsigned* xb_state() { return (volatile LAS unsigned*)(smem + LDS_BYTES - 16); }
__device__ __forceinline__ void xcd_barrier_complete(unsigned* bar, unsigned x, unsigned& nloc, unsigned& nx) {
  const unsigned G = gridDim.x;
  unsigned sum, cnt, mine, sp = 0u;
  for (;;) {
    sum = 0u; cnt = 0u; mine = 0u;
#pragma unroll
    for (unsigned j = 0; j < 16; ++j) { const unsigned c = xb_ld(&bar[XB_XCNT(j)]); sum += c; cnt += (c > 0u) ? 1u : 0u; mine = (j == x) ? c : mine; }
    if (sum == G) break;
    __builtin_amdgcn_s_sleep(1);
    if ((++sp & 255u) == 0u) { if (xb_ld(&bar[XB_TMO])) break; if (sp > XB_SPIN_CAP) { atomicAdd(&bar[XB_TMO], 1u); break; } }
  }
  nloc = mine > 0u ? mine : 1u; nx = cnt > 0u ? cnt : 1u;
}
__device__ __forceinline__ void xcd_barrier() {
  asm volatile("s_waitcnt vmcnt(0)" ::: "memory");
  __syncthreads();
  unsigned* bar = kparams()->bar;
  if (tidx() == 0) {
    const unsigned x = xb_xcc_id();
    volatile LAS unsigned* st = xb_state();
    __builtin_amdgcn_s_waitcnt(0);
    unsigned nloc = st[0], nx = st[1];
    if (nloc == 0u) { xcd_barrier_complete(bar, x, nloc, nx); st[0] = nloc; st[1] = nx; }
    const unsigned old = xb_add(&bar[XB_XSUB(x)], 1u);
    const unsigned gen = old / nloc;
    if (old + 1u == (gen + 1u) * nloc) {
      __builtin_amdgcn_fence(__ATOMIC_RELEASE, "agent");
      asm volatile("s_waitcnt vmcnt(0)" ::: "memory");
      const unsigned og = xb_add(&bar[XB_TOP], 1u);
      const unsigned tg = og / nx;
      if (og + 1u == (tg + 1u) * nx) xb_add(&bar[XB_TOPGEN], 1u);
      else XB_SPIN(xb_ld(&bar[XB_TOPGEN]) == tg, bar);
      __builtin_amdgcn_fence(__ATOMIC_ACQUIRE, "agent");
      xb_add(&bar[XB_XGEN(x)], 1u);
      asm volatile("s_waitcnt vmcnt(0)" ::: "memory");
    } else {
      XB_SPIN(xb_ld(&bar[XB_XGEN(x)]) == gen, bar);
      __builtin_amdgcn_fence(__ATOMIC_ACQUIRE, "agent");
      asm volatile("s_waitcnt vmcnt(0)" ::: "memory");
    }
  }
  __syncthreads();
}
#else
__device__ __forceinline__ void xcd_barrier() {}
#endif

#ifndef DIAG
#define DIAG -1
#endif
#define on_(k) ((DIAG < 0 || DIAG == (k)) && (G < 0 || G == (k)))
template <int G>
__device__ __forceinline__ void run_phase(PRef p, int ph) {
  EpiArgs ea{};
  int gem = 0, lda = 1024, K = 1024, nM = 136, nN = 4;
  const bf16_t* A = p.ab; const bf16_t* Bt = p.wgu;
  int mixed = 0, plx = 0, pml = 0, pmj = 0;
  const int only_chain = (ph == 108 || ph == 120);
  switch (ph == 108 ? 8 : ph == 120 ? 20 : ph) {
    case 0: if constexpr (on_(0)) phase_setup(p); break;
    case 1: if constexpr (on_(1)) phase_prep<0>(p, 0, 0, 0, 0, NT, blockIdx.x, gridDim.x); break;
    case 2: case 12: case 15: case 25: {
      int li = ph == 2 ? 0 : ph == 12 ? 1 : ph == 15 ? 2 : 3;
      ea.o16 = p.z; gem = 1; Bt = p.wgu + (size_t)li * 5632 * 1024; nM = ph == 25 ? 128 : 136; nN = 22;
    } break;
    case 3: case 13: case 16: case 26: {
      int li = ph == 3 ? 0 : ph == 13 ? 1 : ph == 16 ? 2 : 3;
      int l = li >> 1, j = (li & 1) * 2;
      ea.modg = p.mod + (size_t)l * 9 * 9216 + (3 * j + 2) * 1024; ea.coef = 0.5f;
      ea.lnidx = ph == 3 ? -1 : ph == 13 ? 1 : ph == 16 ? 2 : 4;
      gem = 2; A = p.z; lda = 2816; K = 2816; Bt = p.wdn + (size_t)li * 1024 * 2816; nM = 128; nN = 4;
    } break;
    case 4: case 14: case 17: {
      int li = ph == 4 ? 0 : ph == 14 ? 1 : 2;
      int l = li >> 1, j = (li & 1) * 2;
      ea.modg = p.mod + (size_t)l * 9 * 9216 + (3 * j + 2) * 1024; ea.coef = 0.5f;
      ea.lnidx = ph == 4 ? -1 : ph == 14 ? 1 : 2;
      gem = 2; A = p.z + (size_t)NL * 2816; lda = 2816; K = 2816; Bt = p.wdn + (size_t)li * 1024 * 2816; nM = 8; nN = 4;
      mixed = 1; plx = ph == 4 ? 0 : ph == 14 ? 2 : 3; pml = ph == 4 ? 0 : 1; pmj = ph == 4 ? 1 : ph == 14 ? 0 : 1;
    } break;
    case 5: ea.o16 = p.z; ea.ncol = 3088; ea.flag = 1; gem = 3; Bt = p.wevin; nN = 13; break;
    case 6: if constexpr (on_(5)) phase_mlconv(p); break;
    case 7: ea.o16 = p.z; gem = 4; A = p.och; lda = 512; K = 512; Bt = p.wqk; nN = 4; break;
    case 8: if constexpr (G < 0 && (DIAG < 0 || DIAG == 7)) phase_mix_even<0>(p, only_chain); else if constexpr (G >= 0 && on_(7)) phase_mix_even<1>(p, 0); else if constexpr (on_(13)) phase_mix_even<2>(p, 0); break;
    case 9: if constexpr (on_(8)) phase_combine<0>(p); break;
    case 10: ea.modg = p.mod + (size_t)0 * 9 * 9216 + 5 * 1024; ea.coef = 1.0f; ea.lnidx = 0; gem = 2; Bt = p.wevout; nM = 128; break;
    case 11:
      ea.modg = p.mod + (size_t)0 * 9 * 9216 + 5 * 1024; ea.coef = 1.0f; ea.lnidx = 0; gem = 2; A = p.ab + (size_t)NL * 1024; Bt = p.wevout; nM = 8;
      mixed = 1; plx = 1; pml = 0; pmj = 2; break;
    case 18: ea.o16 = p.z; ea.ncol = 2560; ea.flag = 0; gem = 3; Bt = p.wodin; nN = 10; break;
    case 19: if constexpr (on_(9)) phase_rope(p); break;
    case 20: if constexpr (on_(10)) phase_mix_odd(p, only_chain); break;
    case 21: if constexpr (on_(11)) phase_combine<1>(p); break;
    case 22: ea.vec = p.glu_b; gem = 5; A = p.z; lda = LDZ; K = 512; Bt = p.wglu; nN = 2; break;
    case 23: ea.modg = p.mod + (size_t)1 * 9 * 9216 + 5 * 1024; ea.coef = 1.0f; ea.lnidx = 3; gem = 2; Bt = p.wodout; nM = 128; break;
    case 24: if constexpr (on_(1)) phase_prep<1>(p, 4, 1, 2, 0, NL, blockIdx.x, gridDim.x); break;
    case 27: if constexpr (on_(1)) phase_prep<2>(p, 5, 0, 0, 0, NL, blockIdx.x, gridDim.x); break;
    default: break;
  }
  const int nb = gridDim.x, bid = blockIdx.x;
  const int row0 = mixed ? NL : 0;
  const int gbid = bid, gnb = mixed ? 32 : nb;
  if (ph == 102) { ea.o16 = p.z; Bt = p.wgu; nN = 22; gem = 6; }
  if (gem == 6) { if constexpr (PROBE_PH == 102) phase_gemm<6>(p, A, lda, Bt, K, nM, nN, ea, 0, bid, nb); }
  if (gem == 1) { if constexpr (on_(2)) phase_gemm<1>(p, A, lda, Bt, K, nM, nN, ea, 0, bid, nb); }
  else if (gem == 2) { if constexpr (on_(3)) { if (!mixed || bid < 32) phase_gemm<2>(p, A, lda, Bt, K, nM, nN, ea, row0, gbid, gnb); } }
  else if (gem == 3) { if constexpr (on_(4)) phase_gemm<3>(p, A, lda, Bt, K, nM, nN, ea, 0, bid, nb); }
  else if (gem == 4) { if constexpr (on_(6)) phase_gemm<4>(p, A, lda, Bt, K, nM, nN, ea, 0, bid, nb); }
  else if (gem == 5) { if constexpr (on_(12)) phase_gemm<5>(p, A, lda, Bt, K, nM, nN, ea, 0, bid, nb); }
  if (mixed) {
    if constexpr (on_(1)) {
      if (bid >= 32) phase_prep<1>(p, plx, pml, pmj, 0, NL, bid - 32, nb - 32);
      xcd_barrier();
      phase_prep<1>(p, plx, pml, pmj, NL, NT, bid, nb);
    }
  }
}

template <int G>
__global__ void __launch_bounds__(512) mega(Params p, int ph_lo, int ph_hi) {
  for (int ph = ph_lo; ph < ph_hi; ++ph) run_phase<G>(*kparams(), ph);
}

#if MK_COOP
template <int PH>
__device__ __forceinline__ void run_all(cg::grid_group& grid) {
  if constexpr (PH == 1) {
    volatile LAS unsigned* st = xb_state();
    unsigned* bar = kparams()->bar;
    if (tidx() == 0) { st[0] = 0u; st[1] = 0u; (void)xb_add(&bar[XB_XCNT(xb_xcc_id())], 1u); }
    __syncthreads();
  }
  run_phase<-1>(*kparams(), PH);
  if constexpr (PH + 1 < NPHASE) {
    if constexpr (PH == 0) grid.sync(); else xcd_barrier();
    run_all<PH + 1>(grid);
  }
}
__global__ void __launch_bounds__(512) mega_coop(Params p) {
  __builtin_assume(__builtin_amdgcn_workitem_id_y() == 0);
  __builtin_assume(__builtin_amdgcn_workitem_id_z() == 0);
  cg::grid_group grid = cg::this_grid();
  run_all<0>(grid);
#pragma unroll 1
  for (int i = 0; i < PROBE_N; ++i) { xcd_barrier(); run_phase<-1>(*kparams(), PROBE_PH); }
}
#endif

extern "C" void kernel_launch(void* const* d_in, const int* in_sizes, int n_in, void* d_out, int out_size,
                              void* d_ws, size_t ws_size, hipStream_t stream) {
  Params p{};
  const float** ip = (const float**)&p;
  for (int i = 0; i < 35; ++i) ip[i] = (const float*)d_in[i];
  p.out = (float*)d_out;
  char* w = (char*)d_ws;
  size_t off = 0;
  auto take = [&](size_t bytes) { char* r = w + off; off += (bytes + 255) & ~(size_t)255; return r; };
  p.mod = (float*)take((size_t)2 * 9 * 9216 * 4);
  p.rope = (float*)take(64 * 32 * 2 * 4);
  p.hsc = (float*)take((size_t)2048 * 1024 * 4);
  p.gates = (float*)take((size_t)NT * 16 * 4);
  p.wgu = (bf16_t*)take((size_t)4 * 5632 * 1024 * 2);
  p.wdn = (bf16_t*)take((size_t)4 * 1024 * 2816 * 2);
  p.wevin = (bf16_t*)take((size_t)3328 * 1024 * 2);
  p.wodin = (bf16_t*)take((size_t)2560 * 1024 * 2);
  p.wevout = (bf16_t*)take((size_t)1024 * 1024 * 2);
  p.wodout = (bf16_t*)take((size_t)1024 * 1024 * 2);
  p.wqk = (bf16_t*)take((size_t)1024 * 512 * 2);
  p.wglu = (bf16_t*)take((size_t)512 * 512 * 2);
  p.z = (bf16_t*)take((size_t)NT * LDZ * 2);
  p.ab = (bf16_t*)take((size_t)NT * 1024 * 2);
  p.och = (bf16_t*)take((size_t)2 * NT * 512 * 2);
  p.vt = (bf16_t*)take((size_t)2 * NT * 512 * 2);
  p.bar = (unsigned*)take((size_t)3456 * 4);
  p.stats = (float*)take((size_t)NT * 2 * 4);
  if (off > ws_size) { fprintf(stderr, "workspace too small: need %zu have %zu\n", off, ws_size); return; }
#if MK_COOP
  (void)hipFuncSetAttribute((const void*)mega_coop, hipFuncAttributeMaxDynamicSharedMemorySize, LDS_BYTES);
  int dev = 0, cus = 0, per_cu = 0;
  hipGetDevice(&dev);
  hipDeviceGetAttribute(&cus, hipDeviceAttributeMultiprocessorCount, dev);
  hipOccupancyMaxActiveBlocksPerMultiprocessor(&per_cu, mega_coop, 512, LDS_BYTES);
  int grid = cus * (per_cu > 0 ? 1 : 0);
  if (grid <= 0) { fprintf(stderr, "occupancy query failed\n"); return; }
  void* args[] = {&p};
  hipError_t e = hipLaunchCooperativeKernel((void*)mega_coop, dim3(grid), dim3(512), args, LDS_BYTES, stream);
  if (e != hipSuccess) fprintf(stderr, "cooperative launch failed: %s (grid %d)\n", hipGetErrorString(e), grid);
#else
  static const int grp[NPHASE] = {0, 1, 2, 3, 1, 4, 5, 6, 7, 8, 3, 1, 2, 3, 1, 2, 3, 1, 4, 9, 10, 11, 12, 3, 1, 2, 3, 1};
#define LG(k) case k: (void)hipFuncSetAttribute((const void*)mega<k>, hipFuncAttributeMaxDynamicSharedMemorySize, LDS_BYTES); \
    mega<k><<<256, 512, LDS_BYTES, stream>>>(p, ph, ph + 1); break;
  for (int ph = 0; ph < NPHASE; ++ph) {
    if (ph == 8) { (void)hipFuncSetAttribute((const void*)mega<13>, hipFuncAttributeMaxDynamicSharedMemorySize, LDS_BYTES);
      mega<13><<<256, 512, LDS_BYTES, stream>>>(p, ph, ph + 1); }
    switch (grp[ph]) { LG(0) LG(1) LG(2) LG(3) LG(4) LG(5) LG(6) LG(7) LG(8) LG(9) LG(10) LG(11) LG(12) }
  }
#endif
}
```

```cpp
#include <hip/hip_runtime.h>
#include <hip/hip_cooperative_groups.h>
#include <stdint.h>
#include <stdio.h>
namespace cg = cooperative_groups;

#ifndef MK_COOP
#define MK_COOP 1
#endif

typedef unsigned short bf16_t;
typedef __attribute__((ext_vector_type(8))) short bf16x8;
typedef __attribute__((ext_vector_type(4))) short bf16x4;
typedef __attribute__((ext_vector_type(4))) float f32x4;

constexpr int NL = 32768, NT = 34816, LDZ = 3088;
constexpr int PK = 136;
constexpr int LDS_BYTES = 155648;
constexpr int NPHASE = 28;
#ifndef PROBE_N
#define PROBE_N 0
#define PROBE_PH 0
#endif

struct Params {
  const float *x, *c, *ctx, *c_ctx, *ada_w, *ada_b, *wg, *wu, *wd, *ln_g, *ln_b,
      *ev_w_in, *ev_w_out, *rpb, *conv_w, *conv_b, *wq, *wk, *i_bias, *f_bias, *ml_gn,
      *od_w_in, *od_w_out, *lam_re, *lam_im, *log_dt, *b_re, *b_im, *c_re, *c_im,
      *s5_d, *glu_w, *glu_b, *decay_logit, *ret_gn;
  float* out;
  float *mod, *rope, *hsc, *gates;
  bf16_t *wgu, *wdn, *wevin, *wodin, *wevout, *wodout, *wqk, *wglu;
  bf16_t *z, *ab, *och, *vt;
  float* stats;
  unsigned* bar;
};

typedef const __attribute__((address_space(4))) Params CParams;
typedef CParams& PRef;
__device__ __forceinline__ CParams* kparams() {
  CParams* q = (CParams*)__builtin_amdgcn_kernarg_segment_ptr();
  asm volatile("" : "+s"(q));
  return q;
}

#define LAS __attribute__((address_space(3)))
extern __shared__ __attribute__((aligned(16))) char smem[];
__device__ __forceinline__ int tidx() { int t = __builtin_amdgcn_workitem_id_x(); asm volatile("" : "+v"(t)); return t; }

__device__ __forceinline__ bf16_t f2bf(float f) {
  uint32_t u = __float_as_uint(f);
  u += 0x7fffu + ((u >> 16) & 1u);
  return (bf16_t)(u >> 16);
}
typedef float f32x2_ __attribute__((ext_vector_type(2)));
typedef __bf16 bf16x2_ __attribute__((ext_vector_type(2)));
__device__ __forceinline__ uint32_t cvt_pk_bf16(float lo, float hi) {
  f32x2_ v = {lo, hi};
  return __builtin_bit_cast(uint32_t, __builtin_convertvector(v, bf16x2_));
}
__device__ __forceinline__ float bf2f(bf16_t h) { return __uint_as_float(((uint32_t)h) << 16); }
__device__ __forceinline__ float sigmoidf_(float x) { return __builtin_amdgcn_rcpf(1.0f + __expf(-x)); }
__device__ __forceinline__ float siluf_(float x) { return x * __builtin_amdgcn_rcpf(1.0f + __expf(-x)); }
__device__ __forceinline__ float log_sigmoidf_(float x) { return fminf(x, 0.0f) - log1pf(__expf(-fabsf(x))); }
typedef __attribute__((ext_vector_type(2))) uint32_t u32x2;
typedef __attribute__((ext_vector_type(4))) uint32_t u32x4;
__device__ __forceinline__ bf16x4 pack4(f32x4 a) {
  u32x2 w; w[0] = cvt_pk_bf16(a[0], a[1]); w[1] = cvt_pk_bf16(a[2], a[3]);
  return __builtin_bit_cast(bf16x4, w);
}
__device__ __forceinline__ bf16x8 pack8(const float* a) {
  u32x4 w; w[0] = cvt_pk_bf16(a[0], a[1]); w[1] = cvt_pk_bf16(a[2], a[3]); w[2] = cvt_pk_bf16(a[4], a[5]); w[3] = cvt_pk_bf16(a[6], a[7]);
  return __builtin_bit_cast(bf16x8, w);
}
__device__ __forceinline__ float* hs_ptr(PRef p, int row) {
  return row < NL ? p.out + (size_t)row * 1024 : p.hsc + (size_t)(row - NL) * 1024;
}
__device__ __forceinline__ int mod_row(int row) { return row < NL ? (row >> 12) : 8; }
__device__ __forceinline__ int chain_row(int b, int d, int pos) {
  if (pos < 256) { int t = d ? 255 - pos : pos; return NL + b * 256 + t; }
  int t = pos - 256; if (d) t = 4095 - t; return b * 4096 + t;
}
__device__ __forceinline__ float wave_sum(float v) {
#pragma unroll
  for (int o = 32; o > 0; o >>= 1) v += __shfl_xor(v, o);
  return v;
}
__device__ __forceinline__ void sincos_d(double x, float* s, float* c) {
  const double TWO_PI = 6.283185307179586476925;
  double n = rint(x * (1.0 / TWO_PI));
  double r = x - n * TWO_PI;
  double r2 = r * r, ts = r, tc = 1.0, ss = r, cc = 1.0;
#pragma unroll
  for (int i = 1; i <= 13; ++i) {
    tc *= -r2 * (1.0 / (double)((2 * i - 1) * (2 * i)));  cc += tc;
    ts *= -r2 * (1.0 / (double)((2 * i) * (2 * i + 1)));  ss += ts;
  }
  *s = (float)ss; *c = (float)cc;
}

template <int GU>
__device__ __forceinline__ void conv_plain(const float* __restrict__ src, const float* __restrict__ src2, int ld, bf16_t* __restrict__ dst, int N, int K, int rot) {
  const int nb = gridDim.x;
  const int items = N * (K >> 4);
  for (int it = ((blockIdx.x + rot) % nb) * 512 + tidx(); it < items; it += nb * 512) {
    const int n = it % N, kg = it / N;
    const float* sp = src; int scol = n;
    if (GU) { scol = (n >> 8) * 128 + (n & 127); sp = ((n >> 7) & 1) ? src2 : src; }
    sp += (size_t)(kg * 16) * ld + scol;
    float v[16];
#pragma unroll
    for (int i = 0; i < 16; ++i) v[i] = sp[(size_t)i * ld];
    bf16_t* dp = dst + (size_t)n * K + kg * 16;
    *(bf16x8*)dp = pack8(v); *(bf16x8*)(dp + 8) = pack8(v + 8);
  }
}

__device__ __forceinline__ void phase_setup(PRef p) {
  const int tid = tidx(), nb = gridDim.x, bid = blockIdx.x;
  {
    float* ss = (float*)smem;
    float* red = ss + 9216;
    for (int i = tid; i < 9216; i += 512) {
      int r = i >> 10, k = i & 1023;
      float v = r < 8 ? p.c[r * 1024 + k] : p.c_ctx[k];
      ss[i] = siluf_(v);
    }
    __syncthreads();
    for (int task = bid; task < 288; task += nb) {
      int l = task / 144, j0 = (task % 144) * 64, jj = tid & 63, kg = tid >> 6;
      float acc[9];
#pragma unroll
      for (int r = 0; r < 9; ++r) acc[r] = 0.f;
      const float* w = p.ada_w + ((size_t)l * 1024 + kg * 128) * 9216 + j0 + jj;
      for (int k = 0; k < 128; ++k) {
        float wv = w[(size_t)k * 9216];
#pragma unroll
        for (int r = 0; r < 9; ++r) acc[r] += ss[r * 1024 + kg * 128 + k] * wv;
      }
#pragma unroll
      for (int r = 0; r < 9; ++r) red[(kg * 9 + r) * 64 + jj] = acc[r];
      __syncthreads();
      for (int i = tid; i < 576; i += 512) {
        int r = i >> 6, j2 = i & 63;
        float s = p.ada_b[l * 9216 + j0 + j2];
#pragma unroll
        for (int g = 0; g < 8; ++g) s += red[(g * 9 + r) * 64 + j2];
        p.mod[(size_t)(l * 9 + r) * 9216 + j0 + j2] = s;
      }
      __syncthreads();
    }
  }
  if (bid == 0) for (int i = tid; i < 3456; i += 512) p.bar[i] = 0u;
  for (int i = bid * 512 + tid; i < 2048; i += nb * 512) {
    int pos = i >> 5, fi = i & 31;
    float fr = expf(-(float)fi * (1.0f / 32.0f) * 9.210340371976184f);
    float s, c;
    sincos_d((double)pos * (double)fr, &s, &c);
    p.rope[i * 2] = c; p.rope[i * 2 + 1] = s;
  }
  for (int li = 0; li < 4; ++li) {
    conv_plain<1>(p.wg + (size_t)li * 1024 * 2816, p.wu + (size_t)li * 1024 * 2816, 2816, p.wgu + (size_t)li * 5632 * 1024, 5632, 1024, li * 37);
    conv_plain<0>(p.wd + (size_t)li * 2816 * 1024, nullptr, 1024, p.wdn + (size_t)li * 1024 * 2816, 1024, 2816, li * 61 + 13);
  }
  conv_plain<0>(p.ev_w_in, nullptr, 3088, p.wevin, 3088, 1024, 5);
  for (int i = bid * 512 + tid; i < 240 * 1024; i += nb * 512) p.wevin[(size_t)3088 * 1024 + i] = (bf16_t)0;
  conv_plain<0>(p.od_w_in, nullptr, 2560, p.wodin, 2560, 1024, 77);
  conv_plain<0>(p.ev_w_out, nullptr, 1024, p.wevout, 1024, 1024, 131);
  conv_plain<0>(p.od_w_out, nullptr, 1024, p.wodout, 1024, 1024, 171);
  conv_plain<0>(p.glu_w, nullptr, 512, p.wglu, 512, 512, 201);
  for (int i = bid * 512 + tid; i < 1024 * 512; i += nb * 512) {
    int k = i >> 10, n = i & 1023;
    int hh = (n & 511) >> 7, e = n & 127, kh = k >> 7, dd = k & 127;
    float v = 0.f;
    if (kh == hh) v = n < 512 ? p.wq[(hh * 128 + dd) * 128 + e] : p.wk[(hh * 128 + dd) * 128 + e] * 0.08838834764831845f;
    p.wqk[(size_t)n * 512 + k] = f2bf(v);
  }
}

template <int MODE>
__device__ __forceinline__ void phase_prep(PRef p, int lnidx, int ml, int mj, int rbeg, int nrows, int gbid, int gnb) {
  const int lane = tidx() & 63, wid = tidx() >> 6;
  const float* g = p.ln_g + lnidx * 1024;
  const float* bb = p.ln_b + lnidx * 1024;
  constexpr int PR = 4;
  for (int row0 = rbeg + (gbid * 8 + wid) * PR; row0 < nrows; row0 += gnb * 8 * PR) {
    float4 v[PR][4];
    float* hp[PR];
#pragma unroll
    for (int r = 0; r < PR; ++r) {
      const int row = row0 + r;
      hp[r] = hs_ptr(p, row);
      const float* src = MODE == 0 ? (row < NL ? p.x + (size_t)row * 1024 : p.ctx + (size_t)(row - NL) * 1024) : hp[r];
#pragma unroll
      for (int i = 0; i < 4; ++i) v[r][i] = *(const float4*)(src + i * 256 + lane * 4);
    }
    if (MODE != 0) {
      float mu[PR], rstd[PR];
#pragma unroll
      for (int r = 0; r < PR; ++r) {
        float s = 0.f;
#pragma unroll
        for (int i = 0; i < 4; ++i) s += v[r][i].x + v[r][i].y + v[r][i].z + v[r][i].w;
        mu[r] = s;
      }
#pragma unroll
      for (int o = 32; o > 0; o >>= 1) {
#pragma unroll
        for (int r = 0; r < PR; ++r) mu[r] += __shfl_xor(mu[r], o);
      }
#pragma unroll
      for (int r = 0; r < PR; ++r) {
        mu[r] *= (1.0f / 1024.0f);
        float q = 0.f;
#pragma unroll
        for (int i = 0; i < 4; ++i) {
          v[r][i].x -= mu[r]; v[r][i].y -= mu[r]; v[r][i].z -= mu[r]; v[r][i].w -= mu[r];
          q += v[r][i].x * v[r][i].x + v[r][i].y * v[r][i].y + v[r][i].z * v[r][i].z + v[r][i].w * v[r][i].w;
        }
        rstd[r] = q;
      }
#pragma unroll
      for (int o = 32; o > 0; o >>= 1) {
#pragma unroll
        for (int r = 0; r < PR; ++r) rstd[r] += __shfl_xor(rstd[r], o);
      }
#pragma unroll
      for (int r = 0; r < PR; ++r) {
        rstd[r] = rsqrtf(rstd[r] * (1.0f / 1024.0f) + 1e-5f);
        if (MODE == 1 && lane == 0) *(float2*)(p.stats + (size_t)(row0 + r) * 2) = make_float2(mu[r], rstd[r]);
      }
#pragma unroll
      for (int i = 0; i < 4; ++i) {
        float4 gg = *(const float4*)(g + i * 256 + lane * 4), b4 = *(const float4*)(bb + i * 256 + lane * 4);
#pragma unroll
        for (int r = 0; r < PR; ++r) {
          v[r][i].x = v[r][i].x * rstd[r] * gg.x + b4.x; v[r][i].y = v[r][i].y * rstd[r] * gg.y + b4.y;
          v[r][i].z = v[r][i].z * rstd[r] * gg.z + b4.z; v[r][i].w = v[r][i].w * rstd[r] * gg.w + b4.w;
        }
      }
    }
    if (MODE == 2) {
#pragma unroll
      for (int r = 0; r < PR; ++r)
#pragma unroll
        for (int i = 0; i < 4; ++i) *(float4*)(hp[r] + i * 256 + lane * 4) = v[r][i];
    }
    if (MODE != 2) {
      const float* sh = p.mod + (size_t)(ml * 9 + mod_row(row0)) * 9216 + (3 * mj) * 1024;
      const float* sc = sh + 1024;
#pragma unroll
      for (int i = 0; i < 4; ++i) {
        int col = i * 256 + lane * 4;
        float4 s4 = *(const float4*)(sh + col), c4 = *(const float4*)(sc + col);
#pragma unroll
        for (int r = 0; r < PR; ++r) {
          f32x4 o = {v[r][i].x * (1.f + c4.x) + s4.x, v[r][i].y * (1.f + c4.y) + s4.y, v[r][i].z * (1.f + c4.z) + s4.z, v[r][i].w * (1.f + c4.w) + s4.w};
          *(bf16x4*)(p.ab + (size_t)(row0 + r) * 1024 + col) = pack4(o);
        }
      }
    }
  }
}

struct EpiArgs { bf16_t* o16; const float* modg; float coef; int ncol; int flag; const float* vec; int lnidx; };

__device__ __forceinline__ int g_lds_byte(int r, int c) {
  int st = (r >> 4) * 2 + (c >> 5), rr = r & 15, cc = c & 31, ob = rr * 64 + cc * 2;
  return st * 1024 + (ob ^ (((ob >> 9) & 1) << 5));
}
__device__ __forceinline__ void g_stage_rc(int b, int& R, int& C) {
  int st = b / 1024, sb = b % 1024, swz = sb ^ (((sb >> 9) & 1) << 5);
  R = (st >> 1) * 16 + swz / 64; C = (st & 1) * 32 + (swz % 64) / 2;
}

template <int EPI>
__device__ __forceinline__ void gemm_epilogue(PRef p, const EpiArgs& ea, const f32x4 (&acc)[2][2][4][2],
                                              int brow, int bcol, int wr, int wc, int fr, int fq) {
  const int row0 = brow + wr * 64 + fr, col0 = bcol + wc * 32 + 4 * fq;
  if (EPI == 1) {
#pragma unroll
    for (int ai = 0; ai < 2; ++ai)
#pragma unroll
      for (int m = 0; m < 4; ++m) {
        bf16_t* rp = ea.o16 + (size_t)(row0 + ai * 128 + m * 16) * 2816 + (bcol >> 1) + wc * 32 + 4 * fq;
#pragma unroll
        for (int n = 0; n < 2; ++n) {
          f32x4 g = acc[ai][0][m][n], u = acc[ai][1][m][n], o;
#pragma unroll
          for (int j = 0; j < 4; ++j) o[j] = siluf_(g[j]) * u[j];
          *(bf16x4*)(rp + n * 16) = pack4(o);
        }
      }
  } else if (EPI == 2) {
    const float* gv = ea.modg + (size_t)mod_row(brow) * 9216 + col0;
    const bool ident = ea.lnidx < 0;
    const float* lg = p.ln_g + (ident ? 0 : ea.lnidx) * 1024 + col0;
    const float* lb = p.ln_b + (ident ? 0 : ea.lnidx) * 1024 + col0;
    float* hbase = hs_ptr(p, brow) + (size_t)(wr * 64 + fr) * 1024 + (wc * 32 + 4 * fq) + (bcol);
    const float* xbase = (brow < NL ? p.x + (size_t)brow * 1024 : p.ctx + (size_t)(brow - NL) * 1024) + (size_t)(wr * 64 + fr) * 1024 + (wc * 32 + 4 * fq) + (bcol);
    const float* sbase = p.stats + (size_t)(row0) * 2;
#pragma unroll
    for (int bj = 0; bj < 2; ++bj)
#pragma unroll
      for (int n = 0; n < 2; ++n) {
        const int co = bj * 128 + n * 16;
        const f32x4 gc = *(const f32x4*)(gv + co) * ea.coef;
        f32x4 g4 = {1.f, 1.f, 1.f, 1.f}, b4 = {0.f, 0.f, 0.f, 0.f};
        if (!ident) { g4 = *(const f32x4*)(lg + co); b4 = *(const f32x4*)(lb + co); }
#pragma unroll
        for (int ai = 0; ai < 2; ++ai)
#pragma unroll
          for (int m = 0; m < 4; ++m) {
            const size_t ro = (size_t)(ai * 128 + m * 16) * 1024 + co;
            f32x4 h;
            if (ident) h = *(const f32x4*)(xbase + ro);
            else {
              const float2 st = *(const float2*)(sbase + (ai * 128 + m * 16) * 2);
              h = (*(const f32x4*)(hbase + ro) - st.x) * st.y * g4 + b4;
            }
            *(f32x4*)(hbase + ro) = h * 1.4142135623730951f + gc * acc[ai][bj][m][n];
          }
        asm volatile("" ::: "memory");
      }
  } else if (EPI == 3 || EPI == 4) {
    const int cshift = EPI == 4 ? 1024 : 0;
    const bool dovt = EPI == 3 && ea.flag && bcol >= 1024 && bcol < 1536;
#pragma unroll
    for (int ai = 0; ai < 2; ++ai)
#pragma unroll
      for (int m = 0; m < 4; ++m) {
        const int row = row0 + ai * 128 + m * 16;
        bf16_t* rp = ea.o16 + (size_t)row * LDZ + cshift + col0;
#pragma unroll
        for (int bj = 0; bj < 2; ++bj)
#pragma unroll
          for (int n = 0; n < 2; ++n) {
            const int col = col0 + bj * 128 + n * 16;
            bf16x4 o = pack4(acc[ai][bj][m][n]);
            if (EPI == 4 || col < ea.ncol) *(bf16x4*)(rp + bj * 128 + n * 16) = o;
            if (dovt) {
#pragma unroll
              for (int j = 0; j < 4; ++j) p.vt[(size_t)(col - 1024 + j) * NT + row] = (bf16_t)o[j];
            }
          }
        asm volatile("" ::: "memory");
      }
  } else if (EPI == 6) {
    f32x4 t = {0.f, 0.f, 0.f, 0.f};
#pragma unroll
    for (int ai = 0; ai < 2; ++ai)
#pragma unroll
      for (int bj = 0; bj < 2; ++bj)
#pragma unroll
        for (int m = 0; m < 4; ++m)
#pragma unroll
          for (int n = 0; n < 2; ++n) t += acc[ai][bj][m][n];
    if (t[0] + t[1] + t[2] + t[3] == 12345.678f) ea.o16[row0] = 1;
  } else if (EPI == 5) {
    f32x4 bv[2][2];
#pragma unroll
    for (int bj = 0; bj < 2; ++bj)
#pragma unroll
      for (int n = 0; n < 2; ++n) bv[bj][n] = *(const f32x4*)(ea.vec + col0 + bj * 128 + n * 16);
#pragma unroll
    for (int ai = 0; ai < 2; ++ai)
#pragma unroll
      for (int m = 0; m < 4; ++m) {
        const int row = row0 + ai * 128 + m * 16;
#pragma unroll
        for (int bj = 0; bj < 2; ++bj)
#pragma unroll
          for (int n = 0; n < 2; ++n) {
            const int col = col0 + bj * 128 + n * 16;
            bf16x4 gs = *(const bf16x4*)(p.z + (size_t)row * LDZ + col);
            f32x4 a = acc[ai][bj][m][n] + bv[bj][n], o;
#pragma unroll
            for (int j = 0; j < 4; ++j) o[j] = bf2f((bf16_t)gs[j]) * sigmoidf_(a[j]);
            *(bf16x4*)(p.ab + (size_t)row * 1024 + col) = pack4(o);
          }
      }
  }
}

__device__ __forceinline__ bool gemm_unit(int i, int nM, int nN, int gbid, int gnb, int& pm, int& pn) {
  constexpr int NXCD = 8, WGM = 8;
  const int nwg = nM * nN;
  const long L = (long)i * gnb + gbid;
  if (L >= nwg) return false;
  int wgid = (int)L;
  { const int q = nwg / NXCD, r = nwg % NXCD, xcd = wgid % NXCD, off = wgid / NXCD;
    wgid = (xcd < r ? xcd * (q + 1) : r * (q + 1) + (xcd - r) * q) + off; }
  const int nig = WGM * nN, gid = wgid / nig, fm = gid * WGM, gsz = (nM - fm) < WGM ? (nM - fm) : WGM;
  pm = fm + ((wgid % nig) % gsz); pn = (wgid % nig) / gsz;
  return true;
}

template <int EPI>
__device__ __forceinline__ void phase_gemm(PRef p, const bf16_t* __restrict__ A, int lda, const bf16_t* __restrict__ Bt,
                                           int K, int nM, int nN, const EpiArgs& ea, int row0, int gbid, int gnb) {
  constexpr int BK = 64, HALF = 128, HTB = HALF * BK * 2;
  LAS unsigned char* lds = (LAS unsigned char*)smem;
  const int tid = tidx(), wid = __builtin_amdgcn_readfirstlane(tid >> 6), lane = tid & 63, wr = wid >> 2, wc = wid & 3, fr = lane & 15, fq = lane >> 4;
  const int nt = K / BK;
  unsigned voffA[2], voffB[2];
#pragma unroll
  for (int i = 0; i < 2; ++i) { int R, C; g_stage_rc(tid * 16 + i * 8192, R, C);
    voffA[i] = (unsigned)(R * lda + C) * 2u; voffB[i] = (unsigned)(R * K + C) * 2u; }
  const size_t kstep = (size_t)(BK * 2);
  const size_t hstepA = (size_t)HALF * lda * 2, hstepB = (size_t)HALF * K * 2;
  const size_t tstepA = 2 * hstepA, tstepB = 2 * hstepB;
  const unsigned ldsw = (unsigned)wid * 1024u;
  const int aoff = g_lds_byte(wr * 64 + fr, fq * 8), boff = g_lds_byte(wc * 32 + fr, fq * 8);
#define PG8_SA(b, h) (((b) * 2 + (h)) * HTB)
#define PG8_SB(b, h) ((4 + (b) * 2 + (h)) * HTB)
#define PG8_STAGE(bufoff, gbase, voff) do { _Pragma("unroll") for (int _i = 0; _i < 2; ++_i) \
    __builtin_amdgcn_global_load_lds((const unsigned*)((const char*)(gbase) + (voff)[_i]), (LAS unsigned*)(lds + (bufoff) + ldsw + _i * 8192), 16, 0, 0); } while (0)
#define PG8_LDA(dst, b, h) do { _Pragma("unroll") for (int m = 0; m < 4; ++m) _Pragma("unroll") for (int k = 0; k < 2; ++k) dst[m][k] = *(const LAS bf16x8*)(lds + PG8_SA(b, h) + aoff + m * 2048 + k * 1024); } while (0)
#define PG8_LDB(dst, b, h) do { _Pragma("unroll") for (int n = 0; n < 2; ++n) _Pragma("unroll") for (int k = 0; k < 2; ++k) dst[n][k] = *(const LAS bf16x8*)(lds + PG8_SB(b, h) + boff + n * 2048 + k * 1024); } while (0)
#define PG8_MMA(ai, bj, At_, Bt_) do { __builtin_amdgcn_s_setprio(1); _Pragma("unroll") for (int m = 0; m < 4; ++m) _Pragma("unroll") for (int n = 0; n < 2; ++n) _Pragma("unroll") for (int k = 0; k < 2; ++k) \
    acc[ai][bj][m][n] = __builtin_amdgcn_mfma_f32_16x16x32_bf16(Bt_[n][k], At_[m][k], acc[ai][bj][m][n], 0, 0, 0); __builtin_amdgcn_s_setprio(0); } while (0)
#define PG8_WAIT_V(n) asm volatile("s_waitcnt vmcnt(" #n ")" ::: "memory")
#define PG8_WAIT_L(n) asm volatile("s_waitcnt lgkmcnt(" #n ")" ::: "memory")
#define PG8_BAR __builtin_amdgcn_s_barrier()
#define PG8_SCHED __builtin_amdgcn_sched_barrier(0)
  int cpm, cpn, npm = 0, npn = 0, ui = 0;
  if (gemm_unit(0, nM, nN, gbid, gnb, cpm, cpn)) {
    f32x4 acc[2][2][4][2];
#pragma unroll
    for (int a = 0; a < 2; ++a)
#pragma unroll
      for (int b = 0; b < 2; ++b)
#pragma unroll
        for (int m = 0; m < 4; ++m)
#pragma unroll
          for (int n = 0; n < 2; ++n) acc[a][b][m][n] = f32x4{0.f, 0.f, 0.f, 0.f};
    bf16x8 At[4][2], B0[2][2], B1[2][2];
    const char* cA = (const char*)A + (size_t)cpm * tstepA; const char* cB = (const char*)Bt + (size_t)cpn * tstepB;
    PG8_STAGE(PG8_SB(0, 0), cB, voffB); PG8_STAGE(PG8_SA(0, 0), cA, voffA); PG8_STAGE(PG8_SB(0, 1), cB + hstepB, voffB); PG8_STAGE(PG8_SA(0, 1), cA + hstepA, voffA);
    if (wr == 1) PG8_BAR;
    PG8_WAIT_V(4); PG8_BAR;
    PG8_STAGE(PG8_SB(1, 0), cB + kstep, voffB); PG8_STAGE(PG8_SA(1, 0), cA + kstep, voffA); PG8_STAGE(PG8_SB(1, 1), cB + hstepB + kstep, voffB);
    PG8_WAIT_V(6); PG8_BAR;
    for (;;) {
      const bool has_next = gemm_unit(ui + 1, nM, nN, gbid, gnb, npm, npn);
      const char* nA = has_next ? (const char*)A + (size_t)npm * tstepA : cA; const char* nB = has_next ? (const char*)Bt + (size_t)npn * tstepB : cB;
      for (int t = 0; t < nt; t += 2) {
        const bool last = (t == nt - 2);
        const char* a1 = cA + (size_t)(t + 1) * kstep;
        const char* a2 = last ? nA : cA + (size_t)(t + 2) * kstep; const char* b2 = last ? nB : cB + (size_t)(t + 2) * kstep;
        const char* a3 = a2 + kstep; const char* b3 = b2 + kstep;
        PG8_LDB(B0, 0, 0); PG8_SCHED; PG8_LDA(At, 0, 0); PG8_STAGE(PG8_SA(1, 1), a1 + hstepA, voffA);
        PG8_WAIT_L(8); PG8_BAR; PG8_WAIT_L(0); PG8_MMA(0, 0, At, B0); PG8_BAR; PG8_SCHED;
        PG8_LDB(B1, 0, 1); PG8_STAGE(PG8_SB(0, 0), b2, voffB);
        PG8_BAR; PG8_WAIT_L(0); PG8_MMA(0, 1, At, B1); PG8_BAR;
        PG8_LDA(At, 0, 1); PG8_STAGE(PG8_SA(0, 0), a2, voffA);
        PG8_BAR; PG8_WAIT_L(0); PG8_MMA(1, 0, At, B0); PG8_BAR; PG8_SCHED;
        PG8_STAGE(PG8_SB(0, 1), b2 + hstepB, voffB);
        PG8_WAIT_V(6); PG8_BAR; PG8_MMA(1, 1, At, B1); PG8_BAR;
        PG8_LDB(B0, 1, 0); PG8_SCHED; PG8_LDA(At, 1, 0); PG8_STAGE(PG8_SA(0, 1), a2 + hstepA, voffA);
        PG8_WAIT_L(8); PG8_BAR; PG8_WAIT_L(0); PG8_MMA(0, 0, At, B0); PG8_BAR; PG8_SCHED;
        PG8_LDB(B1, 1, 1); PG8_STAGE(PG8_SB(1, 0), b3, voffB);
        PG8_BAR; PG8_WAIT_L(0); PG8_MMA(0, 1, At, B1); PG8_BAR;
        PG8_LDA(At, 1, 1); PG8_STAGE(PG8_SA(1, 0), a3, voffA);
        PG8_BAR; PG8_WAIT_L(0); PG8_MMA(1, 0, At, B0); PG8_BAR; PG8_SCHED;
        PG8_STAGE(PG8_SB(1, 1), b3 + hstepB, voffB);
        PG8_WAIT_V(6); PG8_BAR; PG8_MMA(1, 1, At, B1); PG8_BAR;
      }
      gemm_epilogue<EPI>(p, ea, acc, row0 + cpm * 256, cpn * 256, wr, wc, fr, fq);
      if (!has_next) break;
#pragma unroll
      for (int a = 0; a < 2; ++a)
#pragma unroll
        for (int b = 0; b < 2; ++b)
#pragma unroll
          for (int m = 0; m < 4; ++m)
#pragma unroll
            for (int n = 0; n < 2; ++n) acc[a][b][m][n] = f32x4{0.f, 0.f, 0.f, 0.f};
      cpm = npm; cpn = npn; cA = nA; cB = nB; ++ui;
    }
    PG8_WAIT_V(0);
    if (wr == 0) PG8_BAR;
    PG8_BAR;
  }
  __syncthreads();
#undef PG8_SA
#undef PG8_SB
#undef PG8_STAGE
#undef PG8_LDA
#undef PG8_LDB
#undef PG8_MMA
#undef PG8_WAIT_V
#undef PG8_WAIT_L
#undef PG8_BAR
#undef PG8_SCHED
}

__device__ __forceinline__ void phase_mlconv(PRef p) {
  const int lane = tidx() & 63, wid = tidx() >> 6;
  const int ch = lane * 8;
  float w[5][8], cb[8];
#pragma unroll
  for (int j = 0; j < 5; ++j)
#pragma unroll
    for (int e = 0; e < 8; ++e) w[j][e] = p.conv_w[j * 512 + ch + e];
#pragma unroll
  for (int e = 0; e < 8; ++e) cb[e] = p.conv_b[ch + e];
  for (int row0 = (blockIdx.x * 8 + wid) * 2; row0 < NT; row0 += gridDim.x * 16) {
    int tpos, len;
    if (row0 < NL) { tpos = row0 & 4095; len = 4096; } else { tpos = (row0 - NL) & 255; len = 256; }
    bf16x8 xv[6];
#pragma unroll
    for (int j = 0; j < 6; ++j) {
      int tp = tpos + j - 2;
      xv[j] = bf16x8{0, 0, 0, 0, 0, 0, 0, 0};
      if (tp >= 0 && tp < len) xv[j] = *(const bf16x8*)(p.z + (size_t)(row0 + j - 2) * LDZ + 1536 + ch);
    }
    float gz[2] = {0.f, 0.f};
    if (lane < 16) { gz[0] = bf2f(p.z[(size_t)row0 * LDZ + 3072 + lane]); gz[1] = bf2f(p.z[(size_t)(row0 + 1) * LDZ + 3072 + lane]); }
#pragma unroll
    for (int r = 0; r < 2; ++r) {
      float a[8];
#pragma unroll
      for (int e = 0; e < 8; ++e) a[e] = cb[e];
#pragma unroll
      for (int j = 0; j < 5; ++j)
#pragma unroll
        for (int e = 0; e < 8; ++e) a[e] += w[j][e] * bf2f((bf16_t)xv[r + j][e]);
#pragma unroll
      for (int e = 0; e < 8; ++e) a[e] = siluf_(a[e]);
      *(bf16x8*)(p.och + (size_t)(row0 + r) * 512 + ch) = pack8(a);
      if (lane < 16) {
        float gv = lane < 8 ? gz[r] + p.i_bias[lane] : log_sigmoidf_(gz[r] + p.f_bias[lane - 8]);
        p.gates[(size_t)(row0 + r) * 16 + lane] = gv;
      }
    }
  }
}

typedef __attribute__((ext_vector_type(4))) short s16x4;
__device__ __forceinline__ bf16x8 tr_pair(const bf16_t* base, int byte0, int byte1) {
  s16x4 lo = __builtin_amdgcn_ds_read_tr16_b64_v4i16((LAS s16x4*)((LAS char*)base + byte0));
  s16x4 hi = __builtin_amdgcn_ds_read_tr16_b64_v4i16((LAS s16x4*)((LAS char*)base + byte1));
  bf16x8 r; r[0] = lo[0]; r[1] = lo[1]; r[2] = lo[2]; r[3] = lo[3]; r[4] = hi[0]; r[5] = hi[1]; r[6] = hi[2]; r[7] = hi[3];
  return r;
}
template <int MODE>
__device__ __forceinline__ void chain_block(PRef p, int chain, bf16_t* __restrict__ outbuf) {
  constexpr int NV = MODE == 0 ? 9 : 8;
  constexpr int PKN = 136, PKB = 144, PKV = 160;
  const int tid = tidx(), wid = __builtin_amdgcn_readfirstlane(tid >> 6), lane = tid & 63, fr = lane & 15, fq = lane >> 4;
  const int b = chain >> 3, h = (chain >> 1) & 3, d = chain & 1;
  LAS bf16_t* Kn = (LAS bf16_t*)smem;
  LAS bf16_t* Kb = Kn + 128 * PKN;
  LAS bf16_t* Vn = Kb + 128 * PKB;
  LAS bf16_t* Tt = Vn + 128 * PKV;
  LAS float* sa = (LAS float*)(Tt + 144 * PKN);
  LAS float* sM = sa + 128; LAS float* salpha = sM + 128; LAS float* sbeta = salpha + 128; LAS float* sclamp = sbeta + 128;
  LAS float* sdecay = sclamp + 128;
  const int qcol = MODE == 0 ? 1024 + h * 128 : 512 + h * 128;
  const int kcol = MODE == 0 ? 1536 + h * 128 : 1024 + h * 128;
  const int vcol = MODE == 0 ? 2048 + h * 128 : 1536 + h * 128;
  for (int i = tid; i < 144 * PKN; i += 512) Tt[i] = 0;
  for (int i = tid; i < 128 * 32; i += 512) {
    int r = i >> 5, cc = 128 + (i & 31);
    Vn[r * PKV + cc] = (MODE == 0 && cc == 128) ? (bf16_t)0x3F80 : (bf16_t)0;
  }
  if (MODE == 1 && tid < 128) {
    float lg = log_sigmoidf_(p.decay_logit[d * 4 + h]);
    sa[tid] = -(float)tid * lg; sM[tid] = -(float)tid * lg;
    salpha[tid] = expf((float)(tid + 1) * lg); sbeta[tid] = expf((float)(127 - tid) * lg);
    sclamp[tid] = 1.f;
    if (tid == 0) sdecay[0] = expf(128.f * lg);
  }
  f32x4 T[NV];
#pragma unroll
  for (int i = 0; i < NV; ++i) T[i] = f32x4{0.f, 0.f, 0.f, 0.f};
  float m_prev = 0.f;
  bf16x8 pk[4], pv[4], pq[4];
  float gi0 = 0.f, gf0 = 0.f, gi1 = 0.f, gf1 = 0.f;
  const bf16_t* Z = p.z;
#define CHAIN_ISSUE(cc) do { \
    _Pragma("unroll") for (int i_ = 0; i_ < 4; ++i_) { int idx_ = tid + i_ * 512, pr_ = idx_ >> 4, cv_ = idx_ & 15; \
      size_t ro_ = (size_t)chain_row(b, d, (cc) * 128 + pr_) * LDZ; \
      pk[i_] = *(const bf16x8*)(Z + ro_ + kcol + cv_ * 8); pv[i_] = *(const bf16x8*)(Z + ro_ + vcol + cv_ * 8); } \
    { size_t ro_ = (size_t)chain_row(b, d, (cc) * 128 + wid * 16 + fr) * LDZ + qcol + fq * 8; \
      _Pragma("unroll") for (int kk_ = 0; kk_ < 4; ++kk_) pq[kk_] = *(const bf16x8*)(Z + ro_ + kk_ * 32); } \
    if (MODE == 0 && wid == 0) { \
      int r0_ = chain_row(b, d, (cc) * 128 + 2 * lane), r1_ = chain_row(b, d, (cc) * 128 + 2 * lane + 1); \
      gi0 = p.gates[(size_t)r0_ * 16 + d * 4 + h]; gf0 = p.gates[(size_t)r0_ * 16 + 8 + d * 4 + h]; \
      gi1 = p.gates[(size_t)r1_ * 16 + d * 4 + h]; gf1 = p.gates[(size_t)r1_ * 16 + 8 + d * 4 + h]; } } while (0)
  CHAIN_ISSUE(0);
  __syncthreads();
  for (int c = 0; c < 34; ++c) {
    if (MODE == 0 && wid == 0) {
      float i0 = gi0, f0 = gf0, i1 = gi1, f1 = gf1;
      float c1 = f0 + f1, inc = c1;
#pragma unroll
      for (int o = 1; o < 64; o <<= 1) { float t = __shfl_up(inc, o); if (lane >= o) inc += t; }
      float off = inc - c1, b0 = off + f0, b1 = off + c1;
      float a0 = i0 - b0, a1 = i1 - b1;
      float x1 = fmaxf(a0, a1), mx = x1;
#pragma unroll
      for (int o = 1; o < 64; o <<= 1) { float t = __shfl_up(mx, o); if (lane >= o) mx = fmaxf(mx, t); }
      float offm = __shfl_up(mx, 1); if (lane == 0) offm = -INFINITY;
      float M0 = fmaxf(m_prev, fmaxf(offm, a0)), M1 = fmaxf(M0, a1);
      float bL = __shfl(b1, 63), ML = __shfl(M1, 63);
      sa[2 * lane] = a0; sa[2 * lane + 1] = a1; sM[2 * lane] = M0; sM[2 * lane + 1] = M1;
      salpha[2 * lane] = expf(m_prev - M0); salpha[2 * lane + 1] = expf(m_prev - M1);
      sbeta[2 * lane] = expf(a0 - ML); sbeta[2 * lane + 1] = expf(a1 - ML);
      sclamp[2 * lane] = expf(-(b0 + M0)); sclamp[2 * lane + 1] = expf(-(b1 + M1));
      if (lane == 0) sdecay[0] = expf(m_prev - ML);
      m_prev = bL + ML;
    }
    __syncthreads();
    bf16x8 qf[4];
#pragma unroll
    for (int kk = 0; kk < 4; ++kk) qf[kk] = pq[kk];
#pragma unroll
    for (int i = 0; i < 4; ++i) {
      int idx = tid + i * 512, pr = idx >> 4, cv = idx & 15;
      *(LAS bf16x8*)(Kn + pr * PKN + cv * 8) = pk[i];
      *(LAS bf16x8*)(Vn + pr * PKV + cv * 8) = pv[i];
      float be = sbeta[pr];
      float kbf[8];
#pragma unroll
      for (int e = 0; e < 8; ++e) kbf[e] = bf2f((bf16_t)pk[i][e]) * be;
      *(LAS bf16x8*)(Kb + pr * PKB + cv * 8) = pack8(kbf);
    }
    if (c + 1 < 34) CHAIN_ISSUE(c + 1);
    __syncthreads();
    const int tq = wid * 16 + fr;
    const float Mt = sM[tq];
    bf16x8 pb[4];
    float dsum = 0.f;
#pragma unroll
    for (int ks = 0; ks < 4; ++ks) {
      pb[ks] = bf16x8{0, 0, 0, 0, 0, 0, 0, 0};
      if (2 * ks <= wid) {
#pragma unroll
        for (int hn = 0; hn < 2; ++hn) {
          const int n = 2 * ks + hn;
          f32x4 sacc = f32x4{0.f, 0.f, 0.f, 0.f};
          if (n <= wid) {
#pragma unroll
            for (int kk = 0; kk < 4; ++kk) {
              bf16x8 ka = *(const LAS bf16x8*)(Kn + (n * 16 + fr) * PKN + kk * 32 + fq * 8);
              sacc = __builtin_amdgcn_mfma_f32_16x16x32_bf16(ka, qf[kk], sacc, 0, 0, 0);
            }
          }
          const f32x4 as4 = *(const LAS f32x4*)(sa + n * 16 + fq * 4);
          f32x4 pv4;
#pragma unroll
          for (int j = 0; j < 4; ++j) {
            const int sidx = n * 16 + fq * 4 + j;
            pv4[j] = (n <= wid && sidx <= tq) ? sacc[j] * __expf(as4[j] - Mt) : 0.f;
            dsum += pv4[j];
          }
          bf16x4 pk4 = pack4(pv4);
#pragma unroll
          for (int j = 0; j < 4; ++j) pb[ks][hn * 4 + j] = pk4[j];
        }
      }
    }
    f32x4 O[NV];
    {
      const float al = salpha[tq];
#pragma unroll
      for (int nv = 0; nv < NV; ++nv) {
        f32x4 o = f32x4{0.f, 0.f, 0.f, 0.f};
#pragma unroll
        for (int kk = 0; kk < 4; ++kk) {
          bf16x8 ta = *(const LAS bf16x8*)(Tt + (nv * 16 + fr) * PKN + kk * 32 + fq * 8);
          o = __builtin_amdgcn_mfma_f32_16x16x32_bf16(ta, qf[kk], o, 0, 0, 0);
        }
        O[nv] = o * al;
      }
    }
    float den_inter = 0.f;
    if (MODE == 0) {
      den_inter = __shfl(O[NV - 1][0], fr);
      dsum += __shfl_xor(dsum, 16); dsum += __shfl_xor(dsum, 32);
    }
#pragma unroll
    for (int ks = 0; ks < 4; ++ks) {
      if (2 * ks <= wid) {
        const int r0 = 32 * ks + 4 * fq + (fr >> 2);
#pragma unroll
        for (int nv = 0; nv < NV; ++nv) {
          const int cb = nv * 32 + (fr & 3) * 8;
          bf16x8 va = tr_pair((const bf16_t*)Vn, r0 * (PKV * 2) + cb, (r0 + 16) * (PKV * 2) + cb);
          O[nv] = __builtin_amdgcn_mfma_f32_16x16x32_bf16(va, pb[ks], O[nv], 0, 0, 0);
        }
      }
    }
    {
      const int row = chain_row(b, d, c * 128 + tq);
      float inv = 1.f;
      if (MODE == 0) {
        float den = den_inter + dsum;
        inv = __builtin_amdgcn_rcpf(fmaxf(fabsf(den), sclamp[tq]));
      }
      bf16_t* op = outbuf + ((size_t)d * NT + row) * 512 + h * 128 + fq * 4;
#pragma unroll
      for (int nv = 0; nv < 8; ++nv) *(bf16x4*)(op + nv * 16) = pack4(O[nv] * inv);
    }
    {
      const float dec = sdecay[0];
#pragma unroll
      for (int nv = 0; nv < NV; ++nv) T[nv] = T[nv] * dec;
#pragma unroll
      for (int kk = 0; kk < 4; ++kk) {
        const int r0 = 32 * kk + 8 * fq + (fr >> 2);
        bf16x8 ka = tr_pair((const bf16_t*)Kb, r0 * (PKB * 2) + wid * 32 + (fr & 3) * 8, (r0 + 4) * (PKB * 2) + wid * 32 + (fr & 3) * 8);
#pragma unroll
        for (int nv = 0; nv < NV; ++nv) {
          const int cb = nv * 32 + (fr & 3) * 8;
          bf16x8 vb = tr_pair((const bf16_t*)Vn, r0 * (PKV * 2) + cb, (r0 + 4) * (PKV * 2) + cb);
          T[nv] = __builtin_amdgcn_mfma_f32_16x16x32_bf16(ka, vb, T[nv], 0, 0, 0);
        }
      }
    }
    __syncthreads();
#pragma unroll
    for (int nv = 0; nv < NV; ++nv) *(LAS bf16x4*)(Tt + (nv * 16 + fr) * PKN + wid * 16 + fq * 4) = pack4(T[nv]);
  }
#undef CHAIN_ISSUE
  __syncthreads();
}

template <bool LOCAL>
__device__ __forceinline__ void na_task(PRef p, int task, int lane) {
  constexpr int NG = LOCAL ? 2 : 1;
  const int fr = lane & 15, fq = lane >> 4;
  int b, h, r = 0, wq = 0, qrow, rs = 0, cs0 = 0;
  if (LOCAL) {
    b = task >> 11; h = (task >> 8) & 7; r = (task >> 2) & 63; wq = task & 3;
    qrow = b * 4096 + r * 64 + wq * 16 + fr;
    rs = min(max(r - 4, 0), 56);
    cs0 = wq == 0 ? 0 : (wq == 1 ? 8 : (wq == 2 ? 24 : 32));
  } else {
    b = task >> 7; h = (task >> 4) & 7;
    qrow = NL + b * 256 + (task & 15) * 16 + fr;
  }
  const bf16_t* Z = p.z;
  bf16x8 qf[2];
#pragma unroll
  for (int kk = 0; kk < 2; ++kk) qf[kk] = *(const bf16x8*)(Z + (size_t)qrow * LDZ + h * 64 + kk * 32 + fq * 8);
  f32x4 O[4];
#pragma unroll
  for (int i = 0; i < 4; ++i) O[i] = f32x4{0.f, 0.f, 0.f, 0.f};
  float m_run = -INFINITY, l_run = 0.f;
  constexpr int NGRP = LOCAL ? 4 : 2;
  bf16x8 kc0[8], kc1[8];
#define NA_KLOAD(G_) do { const int g_ = (G_); const bool l_ = LOCAL && g_ < 2; const int c_ = LOCAL ? g_ - 2 : g_; \
    _Pragma("unroll") for (int T = 0; T < 8; ++T) { \
      const int pb_ = l_ ? b * 4096 + (rs + g_ * 4 + (T >> 1)) * 64 + cs0 : NL + b * 256 + (c_ * 8 + (T & ~1)) * 16; \
      const bf16_t* kp_ = Z + (size_t)(pb_ + 8 * (fr >> 2) + (fr & 3) + 4 * (T & 1)) * LDZ + 512 + h * 64 + fq * 8; \
      kc0[T] = *(const bf16x8*)kp_; kc1[T] = *(const bf16x8*)(kp_ + 32); } } while (0)
  NA_KLOAD(0);
#pragma unroll 1
  for (int grp = 0; grp < NGRP; ++grp) {
    const bool loc = LOCAL && grp < 2;
    const int cg0 = LOCAL ? grp - 2 : grp;
    f32x4 S[8];
#pragma unroll
    for (int T = 0; T < 8; ++T) {
      f32x4 a = f32x4{0.f, 0.f, 0.f, 0.f};
      a = __builtin_amdgcn_mfma_f32_16x16x32_bf16(kc0[T], qf[0], a, 0, 0, 0);
      a = __builtin_amdgcn_mfma_f32_16x16x32_bf16(kc1[T], qf[1], a, 0, 0, 0);
      S[T] = a;
    }
    bf16x8 vf[4][4];
#pragma unroll
    for (int ks = 0; ks < 4; ++ks) {
      const int tr0 = loc ? b * 4096 + (rs + grp * 4 + ks) * 64 + cs0 : NL + b * 256 + (cg0 * 8 + 2 * ks) * 16;
#pragma unroll
      for (int dvt = 0; dvt < 4; ++dvt) vf[ks][dvt] = *(const bf16x8*)(p.vt + (size_t)(h * 64 + dvt * 16 + fr) * NT + tr0 + 8 * fq);
    }
    if (grp + 1 < NGRP) NA_KLOAD(grp + 1);
    float mx = -INFINITY;
#pragma unroll
    for (int T = 0; T < 8; ++T) {
      f32x4 a = S[T];
      if (loc) {
        int qc = wq * 16 + fr, st = min(max(qc - 8, 0), 48);
        int roff = rs + grp * 4 + (T >> 1) - r + 7;
#pragma unroll
        for (int j = 0; j < 4; ++j) {
          int kc = cs0 + 8 * fq + 4 * (T & 1) + j;
          bool valid = kc >= st && kc < st + 16;
          float bias = valid ? ((const LAS float*)smem)[roff * 31 + (kc - qc + 15)] : 0.f;
          a[j] = valid ? a[j] * 0.125f + bias : -INFINITY;
        }
      } else {
#pragma unroll
        for (int j = 0; j < 4; ++j) a[j] *= 0.125f;
      }
#pragma unroll
      for (int j = 0; j < 4; ++j) mx = fmaxf(mx, a[j]);
      S[T] = a;
    }
    mx = fmaxf(mx, __shfl_xor(mx, 16)); mx = fmaxf(mx, __shfl_xor(mx, 32));
    float m_new = fmaxf(m_run, mx);
    float scl = __expf(m_run - m_new);
    l_run *= scl;
#pragma unroll
    for (int i = 0; i < 4; ++i)
#pragma unroll
      for (int j = 0; j < 4; ++j) O[i][j] *= scl;
    m_run = m_new;
#pragma unroll
    for (int ks = 0; ks < 4; ++ks) {
      float ev[8];
#pragma unroll
      for (int j = 0; j < 4; ++j) {
        float e0 = __expf(S[2 * ks][j] - m_new), e1 = __expf(S[2 * ks + 1][j] - m_new);
        l_run += e0 + e1;
        ev[j] = e0; ev[4 + j] = e1;
      }
      bf16x8 pb = pack8(ev);
#pragma unroll
      for (int dvt = 0; dvt < 4; ++dvt) O[dvt] = __builtin_amdgcn_mfma_f32_16x16x32_bf16(vf[ks][dvt], pb, O[dvt], 0, 0, 0);
    }
  }
#undef NA_KLOAD
  l_run += __shfl_xor(l_run, 16); l_run += __shfl_xor(l_run, 32);
  float inv = __builtin_amdgcn_rcpf(l_run);
#pragma unroll
  for (int dvt = 0; dvt < 4; ++dvt) {
    *(bf16x4*)(p.ab + (size_t)qrow * 1024 + h * 64 + dvt * 16 + fq * 4) = pack4(O[dvt] * inv);
  }
}

__device__ __forceinline__ void s5_chain(PRef p, int chain, int wslot, int lane) {
  const int d = chain & 1, g = (chain >> 1) & 31, b = chain >> 6;
  const int fr = lane & 15, fq = lane >> 4;
  constexpr int BP = 36, XP = 36;
  float* Bu = (float*)(smem + wslot * 28672);
  bf16_t* X = (bf16_t*)(smem + wslot * 28672 + 128 * BP * 4);
  const int pg = (d * 32 + g) * 64 + lane;
  float ar, ai;
  float erf_, eif_;
  {
    double lr = p.lam_re[pg], li = p.lam_im[pg];
    double dt = (double)expf(p.log_dt[d * 32 + g]);
    double zr = lr * dt, zi = li * dt;
    double mag = (double)expf((float)zr);
    float sn, cs; sincos_d(zi, &sn, &cs);
    double are = mag * cs, aim = mag * sn;
    double lsq = lr * lr + li * li;
    double er = ((are - 1.0) * lr + aim * li) / lsq, ei = (aim * lr - (are - 1.0) * li) / lsq;
    ar = (float)are; ai = (float)aim; erf_ = (float)er; eif_ = (float)ei;
  }
  bf16x8 bbf[8];
#pragma unroll
  for (int ct = 0; ct < 8; ++ct) {
    const int c = ct * 16 + fr, pp = c & 63;
    const float epr = __shfl(erf_, pp), epi = __shfl(eif_, pp);
    bf16x8 v = {0, 0, 0, 0, 0, 0, 0, 0};
    if (fq < 2) {
      const size_t bo = ((size_t)(d * 32 + g) * 64 + pp) * 16 + fq * 8;
      float4 r0 = *(const float4*)(p.b_re + bo), r1 = *(const float4*)(p.b_re + bo + 4);
      float4 i0 = *(const float4*)(p.b_im + bo), i1 = *(const float4*)(p.b_im + bo + 4);
      float brv[8] = {r0.x, r0.y, r0.z, r0.w, r1.x, r1.y, r1.z, r1.w}, biv[8] = {i0.x, i0.y, i0.z, i0.w, i1.x, i1.y, i1.z, i1.w};
#pragma unroll
      for (int e = 0; e < 8; ++e) v[e] = (short)f2bf(c < 64 ? epr * brv[e] - epi * biv[e] : epr * biv[e] + epi * brv[e]);
    }
    bbf[ct] = v;
  }
  bf16x8 cf[4];
#pragma unroll
  for (int kk = 0; kk < 4; ++kk) {
    const int k0 = kk * 32 + fq * 8;
    const float* src = (k0 < 64 ? p.c_re : p.c_im) + ((size_t)(d * 32 + g) * 16 + fr) * 64 + (k0 & 63);
    const float sg = k0 < 64 ? 1.f : -1.f;
    float4 c0 = *(const float4*)src, c1 = *(const float4*)(src + 4);
    float cv[8] = {sg * c0.x, sg * c0.y, sg * c0.z, sg * c0.w, sg * c1.x, sg * c1.y, sg * c1.z, sg * c1.w};
    cf[kk] = pack8(cv);
  }
  float xr = 0.f, xi = 0.f;
  bf16_t* ys = p.vt + (size_t)d * NT * 512;
  const bf16x8 zero8 = {0, 0, 0, 0, 0, 0, 0, 0};
  bf16x8 uf[2], un[2], un2[2], un3[2];
#define S5_ULOAD(dst, SC) do { _Pragma("unroll") for (int rt = 0; rt < 2; ++rt) { dst[rt] = zero8; \
    if (fq < 2 && (SC) < 136) dst[rt] = *(const bf16x8*)(p.z + (size_t)chain_row(b, d, (SC) * 32 + rt * 16 + fr) * LDZ + g * 16 + fq * 8); } } while (0)
  S5_ULOAD(uf, 0); S5_ULOAD(un, 1); S5_ULOAD(un2, 2);
  for (int sc = 0; sc < 136; ++sc) {
    S5_ULOAD(un3, sc + 3);
#pragma unroll
    for (int rt = 0; rt < 2; ++rt)
#pragma unroll
      for (int ct = 0; ct < 8; ++ct) {
        f32x4 a = __builtin_amdgcn_mfma_f32_16x16x32_bf16(uf[rt], bbf[ct], f32x4{0.f, 0.f, 0.f, 0.f}, 0, 0, 0);
        *(f32x4*)(Bu + (ct * 16 + fr) * BP + rt * 16 + fq * 4) = a;
      }
    __builtin_amdgcn_fence(__ATOMIC_SEQ_CST, "wavefront");
    __builtin_amdgcn_wave_barrier();
#pragma unroll
    for (int g4 = 0; g4 < 8; ++g4) {
      const f32x4 br = *(const f32x4*)(Bu + lane * BP + g4 * 4), bi = *(const f32x4*)(Bu + (64 + lane) * BP + g4 * 4);
      float sr[4], si[4];
#pragma unroll
      for (int k = 0; k < 4; ++k) {
        float nr = ar * xr - ai * xi + br[k], ni = ar * xi + ai * xr + bi[k];
        xr = nr; xi = ni; sr[k] = nr; si[k] = ni;
      }
      u32x2 wr, wi;
      wr[0] = cvt_pk_bf16(sr[0], sr[1]); wr[1] = cvt_pk_bf16(sr[2], sr[3]);
      wi[0] = cvt_pk_bf16(si[0], si[1]); wi[1] = cvt_pk_bf16(si[2], si[3]);
      *(u32x2*)(X + lane * XP + g4 * 4) = wr;
      *(u32x2*)(X + (64 + lane) * XP + g4 * 4) = wi;
    }
    __builtin_amdgcn_fence(__ATOMIC_SEQ_CST, "wavefront");
    __builtin_amdgcn_wave_barrier();
#pragma unroll
    for (int tl = 0; tl < 2; ++tl) {
      f32x4 a = f32x4{0.f, 0.f, 0.f, 0.f};
#pragma unroll
      for (int kk = 0; kk < 4; ++kk) {
        const int xo = (kk * 32 + fq * 8 + (fr >> 2)) * (XP * 2) + tl * 32 + (fr & 3) * 8;
        bf16x8 xa = tr_pair((const bf16_t*)X, xo, xo + 4 * (XP * 2));
        a = __builtin_amdgcn_mfma_f32_16x16x32_bf16(xa, cf[kk], a, 0, 0, 0);
      }
#pragma unroll
      for (int j = 0; j < 4; ++j) {
        int row = chain_row(b, d, sc * 32 + tl * 16 + fq * 4 + j);
        ys[(size_t)row * 512 + g * 16 + fr] = f2bf(a[j]);
      }
    }
    __builtin_amdgcn_fence(__ATOMIC_SEQ_CST, "wavefront");
    __builtin_amdgcn_wave_barrier();
    uf[0] = un[0]; uf[1] = un[1]; un[0] = un2[0]; un[1] = un2[1]; un2[0] = un3[0]; un2[1] = un3[1];
  }
#undef S5_ULOAD
}

template <int WHAT>
__device__ __forceinline__ void phase_mix_even(PRef p, int only_chain) {
  const int nb = gridDim.x, bid = blockIdx.x;
  const int wid = tidx() >> 6, lane = tidx() & 63;
  if (WHAT != 2) { if (bid < 64) { chain_block<0>(p, bid, p.och); return; } }
  if (WHAT != 1 && !only_chain) {
    const int b2 = WHAT == 2 ? bid : bid - 64, nb2 = WHAT == 2 ? nb : nb - 64;
    const bool swz = (nb2 & 7) == 0 && WHAT == 0;
    const int xcd = b2 & 7, rank = b2 >> 3, per = nb2 >> 3;
    const int t_lo = swz ? xcd * 2048 + rank * 8 : b2 * 8, t_hi = swz ? (xcd + 1) * 2048 : 16384, t_st = swz ? per * 8 : nb2 * 8;
    for (int base = t_lo; base < t_hi; base += t_st) {
      __syncthreads();
      if (tidx() < 465) ((LAS float*)smem)[tidx()] = p.rpb[((base >> 8) & 7) * 465 + tidx()];
      __syncthreads();
      na_task<true>(p, base + wid, lane);
    }
    for (int task = b2 * 8 + wid; task < 1024; task += nb2 * 8) na_task<false>(p, task, lane);
  }
}
__device__ __forceinline__ void phase_mix_odd(PRef p, int only_chain) {
  const int nb = gridDim.x, bid = blockIdx.x;
  const int wid = tidx() >> 6, lane = tidx() & 63;
  if (bid < 64) { chain_block<1>(p, bid, p.och); return; }
  const int b2 = bid - 64, nb2 = nb - 64;
  if (wid < 4 && !only_chain) for (int ch = b2 + nb2 * wid; ch < 512; ch += nb2 * 4) s5_chain(p, ch, wid, lane);
}

template <int MODE>
__device__ __forceinline__ void phase_combine(PRef p, int nrows) {
  const int lane = tidx() & 63, wid = tidx() >> 6;
  const int ch = lane * 8;
  const float* gn = MODE == 0 ? p.ml_gn : p.ret_gn;
  float gw[8], dsk[8];
#pragma unroll
  for (int e = 0; e < 8; ++e) { gw[e] = gn[ch + e]; dsk[e] = MODE == 1 ? p.s5_d[ch + e] : 0.f; }
  for (int row0 = (blockIdx.x * 8 + wid) * 2; row0 < nrows; row0 += gridDim.x * 16) {
    bf16x8 o0[2], o1[2], zg[2], y0[2], y1[2], uu[2];
#pragma unroll
    for (int r = 0; r < 2; ++r) {
      const int row = row0 + r;
      o0[r] = *(const bf16x8*)(p.och + (size_t)row * 512 + ch);
      o1[r] = *(const bf16x8*)(p.och + ((size_t)NT + row) * 512 + ch);
      zg[r] = *(const bf16x8*)(p.z + (size_t)row * LDZ + (MODE == 0 ? 2560 : 2048) + ch);
      if (MODE == 1) {
        y0[r] = *(const bf16x8*)(p.vt + (size_t)row * 512 + ch);
        y1[r] = *(const bf16x8*)(p.vt + ((size_t)NT + row) * 512 + ch);
        uu[r] = *(const bf16x8*)(p.z + (size_t)row * LDZ + ch);
      }
    }
#pragma unroll
    for (int r = 0; r < 2; ++r) {
      const int row = row0 + r;
      float v[8], s = 0.f;
#pragma unroll
      for (int e = 0; e < 8; ++e) { v[e] = bf2f((bf16_t)o0[r][e]) + bf2f((bf16_t)o1[r][e]); s += v[e]; }
#pragma unroll
      for (int o = 8; o > 0; o >>= 1) s += __shfl_xor(s, o);
      float mu = s * (1.f / 128.f), q = 0.f;
#pragma unroll
      for (int e = 0; e < 8; ++e) { v[e] -= mu; q += v[e] * v[e]; }
#pragma unroll
      for (int o = 8; o > 0; o >>= 1) q += __shfl_xor(q, o);
      float rstd = rsqrtf(q * (1.f / 128.f) + 1e-5f);
      float ov[8];
#pragma unroll
      for (int e = 0; e < 8; ++e) {
        float zz = bf2f((bf16_t)zg[r][e]);
        float gt = MODE == 0 ? sigmoidf_(zz) : siluf_(zz);
        ov[e] = gt * v[e] * rstd * gw[e];
      }
      *(bf16x8*)(p.ab + (size_t)row * 1024 + 512 + ch) = pack8(ov);
      if (MODE == 1) {
        float gsv[8];
#pragma unroll
        for (int e = 0; e < 8; ++e) {
          float y = bf2f((bf16_t)y0[r][e]) + bf2f((bf16_t)y1[r][e]) + dsk[e] * bf2f((bf16_t)uu[r][e]);
          float t = tanhf(0.7978845608028654f * (y + 0.044715f * y * y * y));
          gsv[e] = 0.5f * y * (1.f + t);
        }
        *(bf16x8*)(p.z + (size_t)row * LDZ + ch) = pack8(gsv);
      }
    }
  }
}

__device__ __forceinline__ void phase_rope(PRef p) {
  const int lane = tidx() & 63, wid = tidx() >> 6;
  for (int row = blockIdx.x * 8 + wid; row < NT; row += gridDim.x * 8) {
    const bool lat = row < NL;
    const int t = row & 4095;
    bf16_t* zr = p.z + (size_t)row * LDZ + 512;
    bf16x8 own[2], oth[2];
#pragma unroll
    for (int it = 0; it < 2; ++it) {
      const int e0 = (lane + 64 * it) * 8;
      own[it] = *(const bf16x8*)(zr + e0);
      oth[it] = *(const bf16x8*)(zr + (e0 ^ 32));
    }
#pragma unroll
    for (int it = 0; it < 2; ++it) {
      const int e0 = (lane + 64 * it) * 8;
      const int qk = e0 >> 9, d = e0 & 127, hs = d >> 6, second = (d >> 5) & 1, i0 = d & 31;
      const int pos = hs ? (t & 63) : (t >> 6);
      float o[8];
#pragma unroll
      for (int e = 0; e < 8; ++e) {
        float xo = bf2f((bf16_t)own[it][e]), xp = bf2f((bf16_t)oth[it][e]);
        float r = xo;
        if (lat) {
          const float2 cs = *(const float2*)(p.rope + (pos * 32 + i0 + e) * 2);
          r = second ? xo * cs.x + xp * cs.y : xo * cs.x - xp * cs.y;
        }
        o[e] = qk ? r * 0.08838834764831845f : r;
      }
      *(bf16x8*)(zr + e0) = pack8(o);
    }
  }
}

#if MK_COOP
#define XB_TMO      128
#define XB_XCNT(j)  (256  + 64 * (j))
#define XB_XSUB(j)  (1280 + 64 * (j))
#define XB_XGEN(j)  (2304 + 64 * (j))
#define XB_TOP      3328
#define XB_TOPGEN   3392
#define XCD_BAR_WORDS 3456
#define XB_SPIN_CAP (1u << 21)
__device__ __forceinline__ unsigned xb_ld(unsigned* q)              { return __hip_atomic_load(q, __ATOMIC_RELAXED, __HIP_MEMORY_SCOPE_AGENT); }
__device__ __forceinline__ unsigned xb_add(unsigned* q, unsigned v) { return __hip_atomic_fetch_add(q, v, __ATOMIC_RELAXED, __HIP_MEMORY_SCOPE_AGENT); }
__device__ __forceinline__ unsigned xb_xcc_id() { return (unsigned)__builtin_amdgcn_s_getreg((3 << 11) | 20) & 0xFu; }
#define XB_SPIN(cond, bar) do { unsigned _sp = 0; while (cond) { __builtin_amdgcn_s_sleep(1); \
    if ((++_sp & 255u) == 0u) { if (xb_ld(&(bar)[XB_TMO])) break; if (_sp > XB_SPIN_CAP) { atomicAdd(&(bar)[XB_TMO], 1u); break; } } } } while (0)
__device__ __forceinline__ volatile LAS unsigned* xb_state() { return (volatile LAS unsigned*)(smem + LDS_BYTES - 16); }
__device__ __forceinline__ void xcd_barrier_complete(unsigned* bar, unsigned x, unsigned& nloc, unsigned& nx) {
  const unsigned G = gridDim.x;
  unsigned sum, cnt, mine, sp = 0u;
  for (;;) {
    sum = 0u; cnt = 0u; mine = 0u;
#pragma unroll
    for (unsigned j = 0; j < 16; ++j) { const unsigned c = xb_ld(&bar[XB_XCNT(j)]); sum += c; cnt += (c > 0u) ? 1u : 0u; mine = (j == x) ? c : mine; }
    if (sum == G) break;
    __builtin_amdgcn_s_sleep(1);
    if ((++sp & 255u) == 0u) { if (xb_ld(&bar[XB_TMO])) break; if (sp > XB_SPIN_CAP) { atomicAdd(&bar[XB_TMO], 1u); break; } }
  }
  nloc = mine > 0u ? mine : 1u; nx = cnt > 0u ? cnt : 1u;
}
__device__ __forceinline__ void xcd_barrier() {
  asm volatile("s_waitcnt vmcnt(0)" ::: "memory");
  __syncthreads();
  unsigned* bar = kparams()->bar;
  if (tidx() == 0) {
    const unsigned x = xb_xcc_id();
    volatile LAS unsigned* st = xb_state();
    __builtin_amdgcn_s_waitcnt(0);
    unsigned nloc = st[0], nx = st[1];
    if (nloc == 0u) { xcd_barrier_complete(bar, x, nloc, nx); st[0] = nloc; st[1] = nx; }
    const unsigned old = xb_add(&bar[XB_XSUB(x)], 1u);
    const unsigned gen = old / nloc;
    if (old + 1u == (gen + 1u) * nloc) {
      __builtin_amdgcn_fence(__ATOMIC_RELEASE, "agent");
      asm volatile("s_waitcnt vmcnt(0)" ::: "memory");
      const unsigned og = xb_add(&bar[XB_TOP], 1u);
      const unsigned tg = og / nx;
      if (og + 1u == (tg + 1u) * nx) xb_add(&bar[XB_TOPGEN], 1u);
      else XB_SPIN(xb_ld(&bar[XB_TOPGEN]) == tg, bar);
      __builtin_amdgcn_fence(__ATOMIC_ACQUIRE, "agent");
      xb_add(&bar[XB_XGEN(x)], 1u);
      asm volatile("s_waitcnt vmcnt(0)" ::: "memory");
    } else {
      XB_SPIN(xb_ld(&bar[XB_XGEN(x)]) == gen, bar);
      __builtin_amdgcn_fence(__ATOMIC_ACQUIRE, "agent");
      asm volatile("s_waitcnt vmcnt(0)" ::: "memory");
    }
  }
  __syncthreads();
}
#else
__device__ __forceinline__ void xcd_barrier() {}
#endif

#ifndef DIAG
#define DIAG -1
#endif
#define on_(k) ((DIAG < 0 || DIAG == (k)) && (G < 0 || G == (k)))
template <int G>
__device__ __forceinline__ void run_phase(PRef p, int ph) {
  EpiArgs ea{};
  int gem = 0, lda = 1024, K = 1024, nM = 136, nN = 4;
  const bf16_t* A = p.ab; const bf16_t* Bt = p.wgu;
  int mixed = 0, plx = 0, pml = 0, pmj = 0;
  const int only_chain = (ph == 108 || ph == 120);
  switch (ph == 108 ? 8 : ph == 120 ? 20 : ph) {
    case 0: if constexpr (on_(0)) phase_setup(p); break;
    case 1: if constexpr (on_(1)) phase_prep<0>(p, 0, 0, 0, 0, NT, blockIdx.x, gridDim.x); break;
    case 2: case 12: case 15: case 25: {
      int li = ph == 2 ? 0 : ph == 12 ? 1 : ph == 15 ? 2 : 3;
      ea.o16 = p.z; gem = 1; Bt = p.wgu + (size_t)li * 5632 * 1024; nM = ph == 25 ? 128 : 136; nN = 22;
    } break;
    case 3: case 13: case 16: case 26: {
      int li = ph == 3 ? 0 : ph == 13 ? 1 : ph == 16 ? 2 : 3;
      int l = li >> 1, j = (li & 1) * 2;
      ea.modg = p.mod + (size_t)l * 9 * 9216 + (3 * j + 2) * 1024; ea.coef = 0.5f;
      ea.lnidx = ph == 3 ? -1 : ph == 13 ? 1 : ph == 16 ? 2 : 4;
      gem = 2; A = p.z; lda = 2816; K = 2816; Bt = p.wdn + (size_t)li * 1024 * 2816; nM = 128; nN = 4;
    } break;
    case 4: case 14: case 17: {
      int li = ph == 4 ? 0 : ph == 14 ? 1 : 2;
      int l = li >> 1, j = (li & 1) * 2;
      ea.modg = p.mod + (size_t)l * 9 * 9216 + (3 * j + 2) * 1024; ea.coef = 0.5f;
      ea.lnidx = ph == 4 ? -1 : ph == 14 ? 1 : 2;
      gem = 2; A = p.z + (size_t)NL * 2816; lda = 2816; K = 2816; Bt = p.wdn + (size_t)li * 1024 * 2816; nM = 8; nN = 4;
      mixed = 1; plx = ph == 4 ? 0 : ph == 14 ? 2 : 3; pml = ph == 4 ? 0 : 1; pmj = ph == 4 ? 1 : ph == 14 ? 0 : 1;
    } break;
    case 5: ea.o16 = p.z; ea.ncol = 3088; ea.flag = 1; gem = 3; Bt = p.wevin; nN = 13; break;
    case 6: if constexpr (on_(5)) phase_mlconv(p); break;
    case 7: ea.o16 = p.z; gem = 4; A = p.och; lda = 512; K = 512; Bt = p.wqk; nN = 4; break;
    case 8: if constexpr (G < 0 && (DIAG < 0 || DIAG == 7)) phase_mix_even<0>(p, only_chain); else if constexpr (G >= 0 && on_(7)) phase_mix_even<1>(p, 0); else if constexpr (on_(13)) phase_mix_even<2>(p, 0); break;
    case 9: if constexpr (on_(8)) phase_combine<0>(p, NT); break;
    case 10: ea.modg = p.mod + (size_t)0 * 9 * 9216 + 5 * 1024; ea.coef = 1.0f; ea.lnidx = 0; gem = 2; Bt = p.wevout; nM = 128; break;
    case 11:
      ea.modg = p.mod + (size_t)0 * 9 * 9216 + 5 * 1024; ea.coef = 1.0f; ea.lnidx = 0; gem = 2; A = p.ab + (size_t)NL * 1024; Bt = p.wevout; nM = 8;
      mixed = 1; plx = 1; pml = 0; pmj = 2; break;
    case 18: ea.o16 = p.z; ea.ncol = 2560; ea.flag = 0; gem = 3; Bt = p.wodin; nN = 10; break;
    case 19: if constexpr (on_(9)) phase_rope(p); break;
    case 20: if constexpr (on_(10)) phase_mix_odd(p, only_chain); break;
    case 21: if constexpr (on_(11)) phase_combine<1>(p, NL); break;
    case 22: ea.vec = p.glu_b; gem = 5; A = p.z; lda = LDZ; K = 512; Bt = p.wglu; nM = 128; nN = 2; break;
    case 23: ea.modg = p.mod + (size_t)1 * 9 * 9216 + 5 * 1024; ea.coef = 1.0f; ea.lnidx = 3; gem = 2; Bt = p.wodout; nM = 128; break;
    case 24: if constexpr (on_(1)) phase_prep<1>(p, 4, 1, 2, 0, NL, blockIdx.x, gridDim.x); break;
    case 27: if constexpr (on_(1)) phase_prep<2>(p, 5, 0, 0, 0, NL, blockIdx.x, gridDim.x); break;
    default: break;
  }
  const int nb = gridDim.x, bid = blockIdx.x;
  const int row0 = mixed ? NL : 0;
  const int gbid = bid, gnb = mixed ? 32 : nb;
  if (ph == 102) { ea.o16 = p.z; Bt = p.wgu; nN = 22; gem = 6; }
  if (gem == 6) { if constexpr (PROBE_PH == 102) phase_gemm<6>(p, A, lda, Bt, K, nM, nN, ea, 0, bid, nb); }
  if (gem == 1) { if constexpr (on_(2)) phase_gemm<1>(p, A, lda, Bt, K, nM, nN, ea, 0, bid, nb); }
  else if (gem == 2) { if constexpr (on_(3)) { if (!mixed || bid < 32) phase_gemm<2>(p, A, lda, Bt, K, nM, nN, ea, row0, gbid, gnb); } }
  else if (gem == 3) { if constexpr (on_(4)) phase_gemm<3>(p, A, lda, Bt, K, nM, nN, ea, 0, bid, nb); }
  else if (gem == 4) { if constexpr (on_(6)) phase_gemm<4>(p, A, lda, Bt, K, nM, nN, ea, 0, bid, nb); }
  else if (gem == 5) { if constexpr (on_(12)) phase_gemm<5>(p, A, lda, Bt, K, nM, nN, ea, 0, bid, nb); }
  if (mixed) {
    if constexpr (on_(1)) {
      if (bid >= 32) phase_prep<1>(p, plx, pml, pmj, 0, NL, bid - 32, nb - 32);
      xcd_barrier();
      phase_prep<1>(p, plx, pml, pmj, NL, NT, bid, nb);
    }
  }
}

template <int G>
__global__ void __launch_bounds__(512) mega(Params p, int ph_lo, int ph_hi) {
  for (int ph = ph_lo; ph < ph_hi; ++ph) run_phase<G>(*kparams(), ph);
}

#if MK_COOP
template <int PH>
__device__ __forceinline__ void run_all(cg::grid_group& grid) {
  if constexpr (PH == 1) {
    volatile LAS unsigned* st = xb_state();
    unsigned* bar = kparams()->bar;
    if (tidx() == 0) { st[0] = 0u; st[1] = 0u; (void)xb_add(&bar[XB_XCNT(xb_xcc_id())], 1u); }
    __syncthreads();
  }
  run_phase<-1>(*kparams(), PH);
  if constexpr (PH + 1 < NPHASE) {
    if constexpr (PH == 0) grid.sync(); else xcd_barrier();
    run_all<PH + 1>(grid);
  }
}
__global__ void __launch_bounds__(512) mega_coop(Params p) {
  __builtin_assume(__builtin_amdgcn_workitem_id_y() == 0);
  __builtin_assume(__builtin_amdgcn_workitem_id_z() == 0);
  cg::grid_group grid = cg::this_grid();
  run_all<0>(grid);
#pragma unroll 1
  for (int i = 0; i < PROBE_N; ++i) { xcd_barrier(); run_phase<-1>(*kparams(), PROBE_PH); }
}
#endif

extern "C" void kernel_launch(void* const* d_in, const int* in_sizes, int n_in, void* d_out, int out_size,
                              void* d_ws, size_t ws_size, hipStream_t stream) {
  Params p{};
  const float** ip = (const float**)&p;
  for (int i = 0; i < 35; ++i) ip[i] = (const float*)d_in[i];
  p.out = (float*)d_out;
  char* w = (char*)d_ws;
  size_t off = 0;
  auto take = [&](size_t bytes) { char* r = w + off; off += (bytes + 255) & ~(size_t)255; return r; };
  p.mod = (float*)take((size_t)2 * 9 * 9216 * 4);
  p.rope = (float*)take(64 * 32 * 2 * 4);
  p.hsc = (float*)take((size_t)2048 * 1024 * 4);
  p.gates = (float*)take((size_t)NT * 16 * 4);
  p.wgu = (bf16_t*)take((size_t)4 * 5632 * 1024 * 2);
  p.wdn = (bf16_t*)take((size_t)4 * 1024 * 2816 * 2);
  p.wevin = (bf16_t*)take((size_t)3328 * 1024 * 2);
  p.wodin = (bf16_t*)take((size_t)2560 * 1024 * 2);
  p.wevout = (bf16_t*)take((size_t)1024 * 1024 * 2);
  p.wodout = (bf16_t*)take((size_t)1024 * 1024 * 2);
  p.wqk = (bf16_t*)take((size_t)1024 * 512 * 2);
  p.wglu = (bf16_t*)take((size_t)512 * 512 * 2);
  p.z = (bf16_t*)take((size_t)NT * LDZ * 2);
  p.ab = (bf16_t*)take((size_t)NT * 1024 * 2);
  p.och = (bf16_t*)take((size_t)2 * NT * 512 * 2);
  p.vt = (bf16_t*)take((size_t)2 * NT * 512 * 2);
  p.bar = (unsigned*)take((size_t)3456 * 4);
  p.stats = (float*)take((size_t)NT * 2 * 4);
  if (off > ws_size) { fprintf(stderr, "workspace too small: need %zu have %zu\n", off, ws_size); return; }
#if MK_COOP
  (void)hipFuncSetAttribute((const void*)mega_coop, hipFuncAttributeMaxDynamicSharedMemorySize, LDS_BYTES);
  int dev = 0, cus = 0, per_cu = 0;
  hipGetDevice(&dev);
  hipDeviceGetAttribute(&cus, hipDeviceAttributeMultiprocessorCount, dev);
  hipOccupancyMaxActiveBlocksPerMultiprocessor(&per_cu, mega_coop, 512, LDS_BYTES);
  int grid = cus * (per_cu > 0 ? 1 : 0);
  if (grid <= 0) { fprintf(stderr, "occupancy query failed\n"); return; }
  void* args[] = {&p};
  hipError_t e = hipLaunchCooperativeKernel((void*)mega_coop, dim3(grid), dim3(512), args, LDS_BYTES, stream);
  if (e != hipSuccess) fprintf(stderr, "cooperative launch failed: %s (grid %d)\n", hipGetErrorString(e), grid);
#else
  static const int grp[NPHASE] = {0, 1, 2, 3, 1, 4, 5, 6, 7, 8, 3, 1, 2, 3, 1, 2, 3, 1, 4, 9, 10, 11, 12, 3, 1, 2, 3, 1};
#define LG(k) case k: (void)hipFuncSetAttribute((const void*)mega<k>, hipFuncAttributeMaxDynamicSharedMemorySize, LDS_BYTES); \
    mega<k><<<256, 512, LDS_BYTES, stream>>>(p, ph, ph + 1); break;
  for (int ph = 0; ph < NPHASE; ++ph) {
    if (ph == 8) { (void)hipFuncSetAttribute((const void*)mega<13>, hipFuncAttributeMaxDynamicSharedMemorySize, LDS_BYTES);
      mega<13><<<256, 512, LDS_BYTES, stream>>>(p, ph, ph + 1); }
    switch (grp[ph]) { LG(0) LG(1) LG(2) LG(3) LG(4) LG(5) LG(6) LG(7) LG(8) LG(9) LG(10) LG(11) LG(12) }
  }
#endif
}
```

```cpp
#include <hip/hip_runtime.h>
#include <hip/hip_cooperative_groups.h>
#include <stdint.h>
#include <stdio.h>
namespace cg = cooperative_groups;

#ifndef MK_COOP
#define MK_COOP 1
#endif

typedef unsigned short bf16_t;
typedef __attribute__((ext_vector_type(8))) short bf16x8;
typedef __attribute__((ext_vector_type(4))) short bf16x4;
typedef __attribute__((ext_vector_type(4))) float f32x4;

constexpr int NL = 32768, NT = 34816, LDZ = 3088;
constexpr int PK = 136;
constexpr int LDS_BYTES = 155648;
constexpr int NPHASE = 28;
#ifndef PROBE_N
#define PROBE_N 0
#define PROBE_PH 0
#endif

struct Params {
  const float *x, *c, *ctx, *c_ctx, *ada_w, *ada_b, *wg, *wu, *wd, *ln_g, *ln_b,
      *ev_w_in, *ev_w_out, *rpb, *conv_w, *conv_b, *wq, *wk, *i_bias, *f_bias, *ml_gn,
      *od_w_in, *od_w_out, *lam_re, *lam_im, *log_dt, *b_re, *b_im, *c_re, *c_im,
      *s5_d, *glu_w, *glu_b, *decay_logit, *ret_gn;
  float* out;
  float *mod, *rope, *hsc, *gates;
  bf16_t *wgu, *wdn, *wevin, *wodin, *wevout, *wodout, *wqk, *wglu;
  bf16_t *z, *ab, *och, *vt;
  float* stats;
  unsigned* bar;
};

typedef const __attribute__((address_space(4))) Params CParams;
typedef CParams& PRef;
__device__ __forceinline__ CParams* kparams() {
  CParams* q = (CParams*)__builtin_amdgcn_kernarg_segment_ptr();
  asm volatile("" : "+s"(q));
  return q;
}

#define LAS __attribute__((address_space(3)))
extern __shared__ __attribute__((aligned(16))) char smem[];
__device__ __forceinline__ int tidx() { int t = __builtin_amdgcn_workitem_id_x(); asm volatile("" : "+v"(t)); return t; }

__device__ __forceinline__ bf16_t f2bf(float f) {
  uint32_t u = __float_as_uint(f);
  u += 0x7fffu + ((u >> 16) & 1u);
  return (bf16_t)(u >> 16);
}
typedef float f32x2_ __attribute__((ext_vector_type(2)));
typedef __bf16 bf16x2_ __attribute__((ext_vector_type(2)));
__device__ __forceinline__ uint32_t cvt_pk_bf16(float lo, float hi) {
  f32x2_ v = {lo, hi};
  return __builtin_bit_cast(uint32_t, __builtin_convertvector(v, bf16x2_));
}
__device__ __forceinline__ float bf2f(bf16_t h) { return __uint_as_float(((uint32_t)h) << 16); }
__device__ __forceinline__ float sigmoidf_(float x) { return __builtin_amdgcn_rcpf(1.0f + __expf(-x)); }
__device__ __forceinline__ float siluf_(float x) { return x * __builtin_amdgcn_rcpf(1.0f + __expf(-x)); }
__device__ __forceinline__ float log_sigmoidf_(float x) { return fminf(x, 0.0f) - log1pf(__expf(-fabsf(x))); }
typedef __attribute__((ext_vector_type(2))) uint32_t u32x2;
typedef __attribute__((ext_vector_type(4))) uint32_t u32x4;
__device__ __forceinline__ bf16x4 pack4(f32x4 a) {
  u32x2 w; w[0] = cvt_pk_bf16(a[0], a[1]); w[1] = cvt_pk_bf16(a[2], a[3]);
  return __builtin_bit_cast(bf16x4, w);
}
__device__ __forceinline__ bf16x8 pack8(const float* a) {
  u32x4 w; w[0] = cvt_pk_bf16(a[0], a[1]); w[1] = cvt_pk_bf16(a[2], a[3]); w[2] = cvt_pk_bf16(a[4], a[5]); w[3] = cvt_pk_bf16(a[6], a[7]);
  return __builtin_bit_cast(bf16x8, w);
}
__device__ __forceinline__ float* hs_ptr(PRef p, int row) {
  return row < NL ? p.out + (size_t)row * 1024 : p.hsc + (size_t)(row - NL) * 1024;
}
__device__ __forceinline__ int mod_row(int row) { return row < NL ? (row >> 12) : 8; }
__device__ __forceinline__ int chain_row(int b, int d, int pos) {
  if (pos < 256) { int t = d ? 255 - pos : pos; return NL + b * 256 + t; }
  int t = pos - 256; if (d) t = 4095 - t; return b * 4096 + t;
}
__device__ __forceinline__ float wave_sum(float v) {
#pragma unroll
  for (int o = 32; o > 0; o >>= 1) v += __shfl_xor(v, o);
  return v;
}
__device__ __forceinline__ void sincos_d(double x, float* s, float* c) {
  const double TWO_PI = 6.283185307179586476925;
  double n = rint(x * (1.0 / TWO_PI));
  double r = x - n * TWO_PI;
  double r2 = r * r, ts = r, tc = 1.0, ss = r, cc = 1.0;
#pragma unroll
  for (int i = 1; i <= 13; ++i) {
    tc *= -r2 * (1.0 / (double)((2 * i - 1) * (2 * i)));  cc += tc;
    ts *= -r2 * (1.0 / (double)((2 * i) * (2 * i + 1)));  ss += ts;
  }
  *s = (float)ss; *c = (float)cc;
}

template <int GU>
__device__ __forceinline__ void conv_plain(const float* __restrict__ src, const float* __restrict__ src2, int ld, bf16_t* __restrict__ dst, int N, int K, int rot) {
  const int nb = gridDim.x;
  const int items = N * (K >> 4);
  for (int it = ((blockIdx.x + rot) % nb) * 512 + tidx(); it < items; it += nb * 512) {
    const int n = it % N, kg = it / N;
    const float* sp = src; int scol = n;
    if (GU) { scol = (n >> 8) * 128 + (n & 127); sp = ((n >> 7) & 1) ? src2 : src; }
    sp += (size_t)(kg * 16) * ld + scol;
    float v[16];
#pragma unroll
    for (int i = 0; i < 16; ++i) v[i] = sp[(size_t)i * ld];
    bf16_t* dp = dst + (size_t)n * K + kg * 16;
    *(bf16x8*)dp = pack8(v); *(bf16x8*)(dp + 8) = pack8(v + 8);
  }
}

__device__ __forceinline__ void phase_setup(PRef p) {
  const int tid = tidx(), nb = gridDim.x, bid = blockIdx.x;
  {
    float* ss = (float*)smem;
    float* red = ss + 9216;
    for (int i = tid; i < 9216; i += 512) {
      int r = i >> 10, k = i & 1023;
      float v = r < 8 ? p.c[r * 1024 + k] : p.c_ctx[k];
      ss[i] = siluf_(v);
    }
    __syncthreads();
    for (int task = bid; task < 288; task += nb) {
      int l = task / 144, j0 = (task % 144) * 64, jj = tid & 63, kg = tid >> 6;
      float acc[9];
#pragma unroll
      for (int r = 0; r < 9; ++r) acc[r] = 0.f;
      const float* w = p.ada_w + ((size_t)l * 1024 + kg * 128) * 9216 + j0 + jj;
      for (int k = 0; k < 128; ++k) {
        float wv = w[(size_t)k * 9216];
#pragma unroll
        for (int r = 0; r < 9; ++r) acc[r] += ss[r * 1024 + kg * 128 + k] * wv;
      }
#pragma unroll
      for (int r = 0; r < 9; ++r) red[(kg * 9 + r) * 64 + jj] = acc[r];
      __syncthreads();
      for (int i = tid; i < 576; i += 512) {
        int r = i >> 6, j2 = i & 63;
        float s = p.ada_b[l * 9216 + j0 + j2];
#pragma unroll
        for (int g = 0; g < 8; ++g) s += red[(g * 9 + r) * 64 + j2];
        p.mod[(size_t)(l * 9 + r) * 9216 + j0 + j2] = s;
      }
      __syncthreads();
    }
  }
  if (bid == 0) for (int i = tid; i < 3456; i += 512) p.bar[i] = 0u;
  for (int i = bid * 512 + tid; i < 2048; i += nb * 512) {
    int pos = i >> 5, fi = i & 31;
    float fr = expf(-(float)fi * (1.0f / 32.0f) * 9.210340371976184f);
    float s, c;
    sincos_d((double)pos * (double)fr, &s, &c);
    p.rope[i * 2] = c; p.rope[i * 2 + 1] = s;
  }
  for (int li = 0; li < 4; ++li) {
    conv_plain<1>(p.wg + (size_t)li * 1024 * 2816, p.wu + (size_t)li * 1024 * 2816, 2816, p.wgu + (size_t)li * 5632 * 1024, 5632, 1024, li * 37);
    conv_plain<0>(p.wd + (size_t)li * 2816 * 1024, nullptr, 1024, p.wdn + (size_t)li * 1024 * 2816, 1024, 2816, li * 61 + 13);
  }
  conv_plain<0>(p.ev_w_in, nullptr, 3088, p.wevin, 3088, 1024, 5);
  for (int i = bid * 512 + tid; i < 240 * 1024; i += nb * 512) p.wevin[(size_t)3088 * 1024 + i] = (bf16_t)0;
  conv_plain<0>(p.od_w_in, nullptr, 2560, p.wodin, 2560, 1024, 77);
  conv_plain<0>(p.ev_w_out, nullptr, 1024, p.wevout, 1024, 1024, 131);
  conv_plain<0>(p.od_w_out, nullptr, 1024, p.wodout, 1024, 1024, 171);
  conv_plain<0>(p.glu_w, nullptr, 512, p.wglu, 512, 512, 201);
  for (int i = bid * 512 + tid; i < 1024 * 512; i += nb * 512) {
    int k = i >> 10, n = i & 1023;
    int hh = (n & 511) >> 7, e = n & 127, kh = k >> 7, dd = k & 127;
    float v = 0.f;
    if (kh == hh) v = n < 512 ? p.wq[(hh * 128 + dd) * 128 + e] : p.wk[(hh * 128 + dd) * 128 + e] * 0.08838834764831845f;
    p.wqk[(size_t)n * 512 + k] = f2bf(v);
  }
}

template <int MODE>
__device__ __forceinline__ void phase_prep(PRef p, int lnidx, int ml, int mj, int rbeg, int nrows, int gbid, int gnb) {
  const int lane = tidx() & 63, wid = tidx() >> 6;
  const float* g = p.ln_g + lnidx * 1024;
  const float* bb = p.ln_b + lnidx * 1024;
  constexpr int PR = 4;
  for (int row0 = rbeg + (gbid * 8 + wid) * PR; row0 < nrows; row0 += gnb * 8 * PR) {
    float4 v[PR][4];
    float* hp[PR];
#pragma unroll
    for (int r = 0; r < PR; ++r) {
      const int row = row0 + r;
      hp[r] = hs_ptr(p, row);
      const float* src = MODE == 0 ? (row < NL ? p.x + (size_t)row * 1024 : p.ctx + (size_t)(row - NL) * 1024) : hp[r];
#pragma unroll
      for (int i = 0; i < 4; ++i) v[r][i] = *(const float4*)(src + i * 256 + lane * 4);
    }
    if (MODE != 0) {
      float mu[PR], rstd[PR];
#pragma unroll
      for (int r = 0; r < PR; ++r) {
        float s = 0.f;
#pragma unroll
        for (int i = 0; i < 4; ++i) s += v[r][i].x + v[r][i].y + v[r][i].z + v[r][i].w;
        mu[r] = s;
      }
#pragma unroll
      for (int o = 32; o > 0; o >>= 1) {
#pragma unroll
        for (int r = 0; r < PR; ++r) mu[r] += __shfl_xor(mu[r], o);
      }
#pragma unroll
      for (int r = 0; r < PR; ++r) {
        mu[r] *= (1.0f / 1024.0f);
        float q = 0.f;
#pragma unroll
        for (int i = 0; i < 4; ++i) {
          v[r][i].x -= mu[r]; v[r][i].y -= mu[r]; v[r][i].z -= mu[r]; v[r][i].w -= mu[r];
          q += v[r][i].x * v[r][i].x + v[r][i].y * v[r][i].y + v[r][i].z * v[r][i].z + v[r][i].w * v[r][i].w;
        }
        rstd[r] = q;
      }
#pragma unroll
      for (int o = 32; o > 0; o >>= 1) {
#pragma unroll
        for (int r = 0; r < PR; ++r) rstd[r] += __shfl_xor(rstd[r], o);
      }
#pragma unroll
      for (int r = 0; r < PR; ++r) {
        rstd[r] = rsqrtf(rstd[r] * (1.0f / 1024.0f) + 1e-5f);
        if (MODE == 1 && lane == 0) *(float2*)(p.stats + (size_t)(row0 + r) * 2) = make_float2(mu[r], rstd[r]);
      }
#pragma unroll
      for (int i = 0; i < 4; ++i) {
        float4 gg = *(const float4*)(g + i * 256 + lane * 4), b4 = *(const float4*)(bb + i * 256 + lane * 4);
#pragma unroll
        for (int r = 0; r < PR; ++r) {
          v[r][i].x = v[r][i].x * rstd[r] * gg.x + b4.x; v[r][i].y = v[r][i].y * rstd[r] * gg.y + b4.y;
          v[r][i].z = v[r][i].z * rstd[r] * gg.z + b4.z; v[r][i].w = v[r][i].w * rstd[r] * gg.w + b4.w;
        }
      }
    }
    if (MODE == 2) {
#pragma unroll
      for (int r = 0; r < PR; ++r)
#pragma unroll
        for (int i = 0; i < 4; ++i) *(float4*)(hp[r] + i * 256 + lane * 4) = v[r][i];
    }
    if (MODE != 2) {
      const float* sh = p.mod + (size_t)(ml * 9 + mod_row(row0)) * 9216 + (3 * mj) * 1024;
      const float* sc = sh + 1024;
#pragma unroll
      for (int i = 0; i < 4; ++i) {
        int col = i * 256 + lane * 4;
        float4 s4 = *(const float4*)(sh + col), c4 = *(const float4*)(sc + col);
#pragma unroll
        for (int r = 0; r < PR; ++r) {
          f32x4 o = {v[r][i].x * (1.f + c4.x) + s4.x, v[r][i].y * (1.f + c4.y) + s4.y, v[r][i].z * (1.f + c4.z) + s4.z, v[r][i].w * (1.f + c4.w) + s4.w};
          *(bf16x4*)(p.ab + (size_t)(row0 + r) * 1024 + col) = pack4(o);
        }
      }
    }
  }
}

struct EpiArgs { bf16_t* o16; const float* modg; float coef; int ncol; int flag; const float* vec; int lnidx; };

__device__ __forceinline__ int g_lds_byte(int r, int c) {
  int st = (r >> 4) * 2 + (c >> 5), rr = r & 15, cc = c & 31, ob = rr * 64 + cc * 2;
  return st * 1024 + (ob ^ (((ob >> 9) & 1) << 5));
}
__device__ __forceinline__ void g_stage_rc(int b, int& R, int& C) {
  int st = b / 1024, sb = b % 1024, swz = sb ^ (((sb >> 9) & 1) << 5);
  R = (st >> 1) * 16 + swz / 64; C = (st & 1) * 32 + (swz % 64) / 2;
}

template <int EPI>
__device__ __forceinline__ void gemm_epilogue(PRef p, const EpiArgs& ea, const f32x4 (&acc)[2][2][4][2],
                                              int brow, int bcol, int wr, int wc, int fr, int fq) {
  const int row0 = brow + wr * 64 + fr, col0 = bcol + wc * 32 + 4 * fq;
  if (EPI == 1) {
#pragma unroll
    for (int ai = 0; ai < 2; ++ai)
#pragma unroll
      for (int m = 0; m < 4; ++m) {
        bf16_t* rp = ea.o16 + (size_t)(row0 + ai * 128 + m * 16) * 2816 + (bcol >> 1) + wc * 32 + 4 * fq;
#pragma unroll
        for (int n = 0; n < 2; ++n) {
          f32x4 g = acc[ai][0][m][n], u = acc[ai][1][m][n], o;
#pragma unroll
          for (int j = 0; j < 4; ++j) o[j] = siluf_(g[j]) * u[j];
          *(bf16x4*)(rp + n * 16) = pack4(o);
        }
      }
  } else if (EPI == 2) {
    const float* gv = ea.modg + (size_t)mod_row(brow) * 9216 + col0;
    const bool ident = ea.lnidx < 0;
    const float* lg = p.ln_g + (ident ? 0 : ea.lnidx) * 1024 + col0;
    const float* lb = p.ln_b + (ident ? 0 : ea.lnidx) * 1024 + col0;
    float* hbase = hs_ptr(p, brow) + (size_t)(wr * 64 + fr) * 1024 + (wc * 32 + 4 * fq) + (bcol);
    const float* xbase = (brow < NL ? p.x + (size_t)brow * 1024 : p.ctx + (size_t)(brow - NL) * 1024) + (size_t)(wr * 64 + fr) * 1024 + (wc * 32 + 4 * fq) + (bcol);
    const float* sbase = p.stats + (size_t)(row0) * 2;
#pragma unroll
    for (int bj = 0; bj < 2; ++bj)
#pragma unroll
      for (int n = 0; n < 2; ++n) {
        const int co = bj * 128 + n * 16;
        const f32x4 gc = *(const f32x4*)(gv + co) * ea.coef;
        f32x4 g4 = {1.f, 1.f, 1.f, 1.f}, b4 = {0.f, 0.f, 0.f, 0.f};
        if (!ident) { g4 = *(const f32x4*)(lg + co); b4 = *(const f32x4*)(lb + co); }
#pragma unroll
        for (int ai = 0; ai < 2; ++ai)
#pragma unroll
          for (int m = 0; m < 4; ++m) {
            const size_t ro = (size_t)(ai * 128 + m * 16) * 1024 + co;
            f32x4 h;
            if (ident) h = *(const f32x4*)(xbase + ro);
            else {
              const float2 st = *(const float2*)(sbase + (ai * 128 + m * 16) * 2);
              h = (*(const f32x4*)(hbase + ro) - st.x) * st.y * g4 + b4;
            }
            *(f32x4*)(hbase + ro) = h * 1.4142135623730951f + gc * acc[ai][bj][m][n];
          }
        asm volatile("" ::: "memory");
      }
  } else if (EPI == 3 || EPI == 4) {
    const int cshift = EPI == 4 ? 1024 : 0;
    const bool dovt = EPI == 3 && ea.flag && bcol >= 1024 && bcol < 1536;
#pragma unroll
    for (int ai = 0; ai < 2; ++ai)
#pragma unroll
      for (int m = 0; m < 4; ++m) {
        const int row = row0 + ai * 128 + m * 16;
        bf16_t* rp = ea.o16 + (size_t)row * LDZ + cshift + col0;
#pragma unroll
        for (int bj = 0; bj < 2; ++bj)
#pragma unroll
          for (int n = 0; n < 2; ++n) {
            const int col = col0 + bj * 128 + n * 16;
            bf16x4 o = pack4(acc[ai][bj][m][n]);
            if (EPI == 4 || col < ea.ncol) *(bf16x4*)(rp + bj * 128 + n * 16) = o;
            if (dovt) {
#pragma unroll
              for (int j = 0; j < 4; ++j) p.vt[(size_t)(col - 1024 + j) * NT + row] = (bf16_t)o[j];
            }
          }
        asm volatile("" ::: "memory");
      }
  } else if (EPI == 6) {
    f32x4 t = {0.f, 0.f, 0.f, 0.f};
#pragma unroll
    for (int ai = 0; ai < 2; ++ai)
#pragma unroll
      for (int bj = 0; bj < 2; ++bj)
#pragma unroll
        for (int m = 0; m < 4; ++m)
#pragma unroll
          for (int n = 0; n < 2; ++n) t += acc[ai][bj][m][n];
    if (t[0] + t[1] + t[2] + t[3] == 12345.678f) ea.o16[row0] = 1;
  } else if (EPI == 5) {
    f32x4 bv[2][2];
#pragma unroll
    for (int bj = 0; bj < 2; ++bj)
#pragma unroll
      for (int n = 0; n < 2; ++n) bv[bj][n] = *(const f32x4*)(ea.vec + col0 + bj * 128 + n * 16);
#pragma unroll
    for (int ai = 0; ai < 2; ++ai)
#pragma unroll
      for (int m = 0; m < 4; ++m) {
        const int row = row0 + ai * 128 + m * 16;
#pragma unroll
        for (int bj = 0; bj < 2; ++bj)
#pragma unroll
          for (int n = 0; n < 2; ++n) {
            const int col = col0 + bj * 128 + n * 16;
            bf16x4 gs = *(const bf16x4*)(p.z + (size_t)row * LDZ + col);
            f32x4 a = acc[ai][bj][m][n] + bv[bj][n], o;
#pragma unroll
            for (int j = 0; j < 4; ++j) o[j] = bf2f((bf16_t)gs[j]) * sigmoidf_(a[j]);
            *(bf16x4*)(p.ab + (size_t)row * 1024 + col) = pack4(o);
          }
      }
  }
}

__device__ __forceinline__ bool gemm_unit(int i, int nM, int nN, int gbid, int gnb, int& pm, int& pn) {
  constexpr int NXCD = 8, WGM = 8;
  const int nwg = nM * nN;
  const long L = (long)i * gnb + gbid;
  if (L >= nwg) return false;
  int wgid = (int)L;
  { const int q = nwg / NXCD, r = nwg % NXCD, xcd = wgid % NXCD, off = wgid / NXCD;
    wgid = (xcd < r ? xcd * (q + 1) : r * (q + 1) + (xcd - r) * q) + off; }
  const int nig = WGM * nN, gid = wgid / nig, fm = gid * WGM, gsz = (nM - fm) < WGM ? (nM - fm) : WGM;
  pm = fm + ((wgid % nig) % gsz); pn = (wgid % nig) / gsz;
  return true;
}

template <int EPI>
__device__ __forceinline__ void phase_gemm(PRef p, const bf16_t* __restrict__ A, int lda, const bf16_t* __restrict__ Bt,
                                           int K, int nM, int nN, const EpiArgs& ea, int row0, int gbid, int gnb) {
  constexpr int BK = 64, HALF = 128, HTB = HALF * BK * 2;
  LAS unsigned char* lds = (LAS unsigned char*)smem;
  const int tid = tidx(), wid = __builtin_amdgcn_readfirstlane(tid >> 6), lane = tid & 63, wr = wid >> 2, wc = wid & 3, fr = lane & 15, fq = lane >> 4;
  const int nt = EPI == 4 ? 4 : K / BK;
  unsigned voffA[2], voffB[2];
#pragma unroll
  for (int i = 0; i < 2; ++i) { int R, C; g_stage_rc(tid * 16 + i * 8192, R, C);
    voffA[i] = (unsigned)(R * lda + C) * 2u; voffB[i] = (unsigned)(R * K + C) * 2u; }
  const size_t kstep = (size_t)(BK * 2);
  const size_t hstepA = (size_t)HALF * lda * 2, hstepB = (size_t)HALF * K * 2;
  const size_t tstepA = 2 * hstepA, tstepB = 2 * hstepB;
  const unsigned ldsw = (unsigned)wid * 1024u;
  const int aoff = g_lds_byte(wr * 64 + fr, fq * 8), boff = g_lds_byte(wc * 32 + fr, fq * 8);
#define PG8_SA(b, h) (((b) * 2 + (h)) * HTB)
#define PG8_SB(b, h) ((4 + (b) * 2 + (h)) * HTB)
#define PG8_STAGE(bufoff, gbase, voff) do { _Pragma("unroll") for (int _i = 0; _i < 2; ++_i) \
    __builtin_amdgcn_global_load_lds((const unsigned*)((const char*)(gbase) + (voff)[_i]), (LAS unsigned*)(lds + (bufoff) + ldsw + _i * 8192), 16, 0, 0); } while (0)
#define PG8_LDA(dst, b, h) do { _Pragma("unroll") for (int m = 0; m < 4; ++m) _Pragma("unroll") for (int k = 0; k < 2; ++k) dst[m][k] = *(const LAS bf16x8*)(lds + PG8_SA(b, h) + aoff + m * 2048 + k * 1024); } while (0)
#define PG8_LDB(dst, b, h) do { _Pragma("unroll") for (int n = 0; n < 2; ++n) _Pragma("unroll") for (int k = 0; k < 2; ++k) dst[n][k] = *(const LAS bf16x8*)(lds + PG8_SB(b, h) + boff + n * 2048 + k * 1024); } while (0)
#define PG8_MMA(ai, bj, At_, Bt_) do { __builtin_amdgcn_s_setprio(1); _Pragma("unroll") for (int m = 0; m < 4; ++m) _Pragma("unroll") for (int n = 0; n < 2; ++n) _Pragma("unroll") for (int k = 0; k < 2; ++k) \
    acc[ai][bj][m][n] = __builtin_amdgcn_mfma_f32_16x16x32_bf16(Bt_[n][k], At_[m][k], acc[ai][bj][m][n], 0, 0, 0); __builtin_amdgcn_s_setprio(0); } while (0)
#define PG8_WAIT_V(n) asm volatile("s_waitcnt vmcnt(" #n ")" ::: "memory")
#define PG8_WAIT_L(n) asm volatile("s_waitcnt lgkmcnt(" #n ")" ::: "memory")
#define PG8_BAR __builtin_amdgcn_s_barrier()
#define PG8_SCHED __builtin_amdgcn_sched_barrier(0)
  int cpm, cpn, npm = 0, npn = 0, ui = 0;
  if (gemm_unit(0, nM, nN, gbid, gnb, cpm, cpn)) {
    f32x4 acc[2][2][4][2];
#pragma unroll
    for (int a = 0; a < 2; ++a)
#pragma unroll
      for (int b = 0; b < 2; ++b)
#pragma unroll
        for (int m = 0; m < 4; ++m)
#pragma unroll
          for (int n = 0; n < 2; ++n) acc[a][b][m][n] = f32x4{0.f, 0.f, 0.f, 0.f};
    bf16x8 At[4][2], B0[2][2], B1[2][2];
    const char* cA = (const char*)A + (size_t)cpm * tstepA + (EPI == 4 ? (cpn & 1) * 512 : 0);
    const char* cB = (const char*)Bt + (size_t)cpn * tstepB + (EPI == 4 ? (cpn & 1) * 512 : 0);
    PG8_STAGE(PG8_SB(0, 0), cB, voffB); PG8_STAGE(PG8_SA(0, 0), cA, voffA); PG8_STAGE(PG8_SB(0, 1), cB + hstepB, voffB); PG8_STAGE(PG8_SA(0, 1), cA + hstepA, voffA);
    if (wr == 1) PG8_BAR;
    PG8_WAIT_V(4); PG8_BAR;
    PG8_STAGE(PG8_SB(1, 0), cB + kstep, voffB); PG8_STAGE(PG8_SA(1, 0), cA + kstep, voffA); PG8_STAGE(PG8_SB(1, 1), cB + hstepB + kstep, voffB);
    PG8_WAIT_V(6); PG8_BAR;
    for (;;) {
      const bool has_next = gemm_unit(ui + 1, nM, nN, gbid, gnb, npm, npn);
      const char* nA = has_next ? (const char*)A + (size_t)npm * tstepA + (EPI == 4 ? (npn & 1) * 512 : 0) : cA;
      const char* nB = has_next ? (const char*)Bt + (size_t)npn * tstepB + (EPI == 4 ? (npn & 1) * 512 : 0) : cB;
      for (int t = 0; t < nt; t += 2) {
        const bool last = (t == nt - 2);
        const char* a1 = cA + (size_t)(t + 1) * kstep;
        const char* a2 = last ? nA : cA + (size_t)(t + 2) * kstep; const char* b2 = last ? nB : cB + (size_t)(t + 2) * kstep;
        const char* a3 = a2 + kstep; const char* b3 = b2 + kstep;
        PG8_LDB(B0, 0, 0); PG8_SCHED; PG8_LDA(At, 0, 0); PG8_STAGE(PG8_SA(1, 1), a1 + hstepA, voffA);
        PG8_WAIT_L(8); PG8_BAR; PG8_WAIT_L(0); PG8_MMA(0, 0, At, B0); PG8_BAR; PG8_SCHED;
        PG8_LDB(B1, 0, 1); PG8_STAGE(PG8_SB(0, 0), b2, voffB);
        PG8_BAR; PG8_WAIT_L(0); PG8_MMA(0, 1, At, B1); PG8_BAR;
        PG8_LDA(At, 0, 1); PG8_STAGE(PG8_SA(0, 0), a2, voffA);
        PG8_BAR; PG8_WAIT_L(0); PG8_MMA(1, 0, At, B0); PG8_BAR; PG8_SCHED;
        PG8_STAGE(PG8_SB(0, 1), b2 + hstepB, voffB);
        PG8_WAIT_V(6); PG8_BAR; PG8_MMA(1, 1, At, B1); PG8_BAR;
        PG8_LDB(B0, 1, 0); PG8_SCHED; PG8_LDA(At, 1, 0); PG8_STAGE(PG8_SA(0, 1), a2 + hstepA, voffA);
        PG8_WAIT_L(8); PG8_BAR; PG8_WAIT_L(0); PG8_MMA(0, 0, At, B0); PG8_BAR; PG8_SCHED;
        PG8_LDB(B1, 1, 1); PG8_STAGE(PG8_SB(1, 0), b3, voffB);
        PG8_BAR; PG8_WAIT_L(0); PG8_MMA(0, 1, At, B1); PG8_BAR;
        PG8_LDA(At, 1, 1); PG8_STAGE(PG8_SA(1, 0), a3, voffA);
        PG8_BAR; PG8_WAIT_L(0); PG8_MMA(1, 0, At, B0); PG8_BAR; PG8_SCHED;
        PG8_STAGE(PG8_SB(1, 1), b3 + hstepB, voffB);
        PG8_WAIT_V(6); PG8_BAR; PG8_MMA(1, 1, At, B1); PG8_BAR;
      }
      gemm_epilogue<EPI>(p, ea, acc, row0 + cpm * 256, cpn * 256, wr, wc, fr, fq);
      if (!has_next) break;
#pragma unroll
      for (int a = 0; a < 2; ++a)
#pragma unroll
        for (int b = 0; b < 2; ++b)
#pragma unroll
          for (int m = 0; m < 4; ++m)
#pragma unroll
            for (int n = 0; n < 2; ++n) acc[a][b][m][n] = f32x4{0.f, 0.f, 0.f, 0.f};
      cpm = npm; cpn = npn; cA = nA; cB = nB; ++ui;
    }
    PG8_WAIT_V(0);
    if (wr == 0) PG8_BAR;
    PG8_BAR;
  }
  __syncthreads();
#undef PG8_SA
#undef PG8_SB
#undef PG8_STAGE
#undef PG8_LDA
#undef PG8_LDB
#undef PG8_MMA
#undef PG8_WAIT_V
#undef PG8_WAIT_L
#undef PG8_BAR
#undef PG8_SCHED
}

__device__ __forceinline__ void phase_mlconv(PRef p) {
  const int lane = tidx() & 63, wid = tidx() >> 6;
  const int ch = lane * 8;
  float w[5][8], cb[8];
#pragma unroll
  for (int j = 0; j < 5; ++j)
#pragma unroll
    for (int e = 0; e < 8; ++e) w[j][e] = p.conv_w[j * 512 + ch + e];
#pragma unroll
  for (int e = 0; e < 8; ++e) cb[e] = p.conv_b[ch + e];
  for (int row0 = (blockIdx.x * 8 + wid) * 2; row0 < NT; row0 += gridDim.x * 16) {
    int tpos, len;
    if (row0 < NL) { tpos = row0 & 4095; len = 4096; } else { tpos = (row0 - NL) & 255; len = 256; }
    bf16x8 xv[6];
#pragma unroll
    for (int j = 0; j < 6; ++j) {
      int tp = tpos + j - 2;
      xv[j] = bf16x8{0, 0, 0, 0, 0, 0, 0, 0};
      if (tp >= 0 && tp < len) xv[j] = *(const bf16x8*)(p.z + (size_t)(row0 + j - 2) * LDZ + 1536 + ch);
    }
    float gz[2] = {0.f, 0.f};
    if (lane < 16) { gz[0] = bf2f(p.z[(size_t)row0 * LDZ + 3072 + lane]); gz[1] = bf2f(p.z[(size_t)(row0 + 1) * LDZ + 3072 + lane]); }
#pragma unroll
    for (int r = 0; r < 2; ++r) {
      float a[8];
#pragma unroll
      for (int e = 0; e < 8; ++e) a[e] = cb[e];
#pragma unroll
      for (int j = 0; j < 5; ++j)
#pragma unroll
        for (int e = 0; e < 8; ++e) a[e] += w[j][e] * bf2f((bf16_t)xv[r + j][e]);
#pragma unroll
      for (int e = 0; e < 8; ++e) a[e] = siluf_(a[e]);
      *(bf16x8*)(p.och + (size_t)(row0 + r) * 512 + ch) = pack8(a);
      if (lane < 16) {
        float gv = lane < 8 ? gz[r] + p.i_bias[lane] : log_sigmoidf_(gz[r] + p.f_bias[lane - 8]);
        p.gates[(size_t)(row0 + r) * 16 + lane] = gv;
      }
    }
  }
}

typedef __attribute__((ext_vector_type(4))) short s16x4;
__device__ __forceinline__ bf16x8 tr_pair(const bf16_t* base, int byte0, int byte1) {
  s16x4 lo = __builtin_amdgcn_ds_read_tr16_b64_v4i16((LAS s16x4*)((LAS char*)base + byte0));
  s16x4 hi = __builtin_amdgcn_ds_read_tr16_b64_v4i16((LAS s16x4*)((LAS char*)base + byte1));
  bf16x8 r; r[0] = lo[0]; r[1] = lo[1]; r[2] = lo[2]; r[3] = lo[3]; r[4] = hi[0]; r[5] = hi[1]; r[6] = hi[2]; r[7] = hi[3];
  return r;
}
template <int MODE>
__device__ __forceinline__ void chain_block(PRef p, int chain, bf16_t* __restrict__ outbuf) {
  constexpr int NV = MODE == 0 ? 9 : 8;
  constexpr int PKN = 136, PKB = 144, PKV = 160;
  const int tid = tidx(), wid = __builtin_amdgcn_readfirstlane(tid >> 6), lane = tid & 63, fr = lane & 15, fq = lane >> 4;
  const int b = chain >> 3, h = (chain >> 1) & 3, d = chain & 1;
  LAS bf16_t* Kn = (LAS bf16_t*)smem;
  LAS bf16_t* Kb = Kn + 128 * PKN;
  LAS bf16_t* Vn = Kb + 128 * PKB;
  LAS bf16_t* Tt = Vn + 128 * PKV;
  LAS float* sa = (LAS float*)(Tt + 144 * PKN);
  LAS float* sM = sa + 128; LAS float* salpha = sM + 128; LAS float* sbeta = salpha + 128; LAS float* sclamp = sbeta + 128;
  LAS float* sdecay = sclamp + 128;
  const int qcol = MODE == 0 ? 1024 + h * 128 : 512 + h * 128;
  const int kcol = MODE == 0 ? 1536 + h * 128 : 1024 + h * 128;
  const int vcol = MODE == 0 ? 2048 + h * 128 : 1536 + h * 128;
  for (int i = tid; i < 144 * PKN; i += 512) Tt[i] = 0;
  for (int i = tid; i < 128 * 32; i += 512) {
    int r = i >> 5, cc = 128 + (i & 31);
    Vn[r * PKV + cc] = (MODE == 0 && cc == 128) ? (bf16_t)0x3F80 : (bf16_t)0;
  }
  if (MODE == 1 && tid < 128) {
    float lg = log_sigmoidf_(p.decay_logit[d * 4 + h]);
    sa[tid] = -(float)tid * lg; sM[tid] = -(float)tid * lg;
    salpha[tid] = expf((float)(tid + 1) * lg); sbeta[tid] = expf((float)(127 - tid) * lg);
    sclamp[tid] = 1.f;
    if (tid == 0) sdecay[0] = expf(128.f * lg);
  }
  f32x4 T[NV];
#pragma unroll
  for (int i = 0; i < NV; ++i) T[i] = f32x4{0.f, 0.f, 0.f, 0.f};
  float m_prev = 0.f;
  bf16x8 pk[4], pv[4], pq[4];
  float gi0 = 0.f, gf0 = 0.f, gi1 = 0.f, gf1 = 0.f;
  const bf16_t* Z = p.z;
#define CHAIN_ISSUE(cc) do { \
    _Pragma("unroll") for (int i_ = 0; i_ < 4; ++i_) { int idx_ = tid + i_ * 512, pr_ = idx_ >> 4, cv_ = idx_ & 15; \
      size_t ro_ = (size_t)chain_row(b, d, (cc) * 128 + pr_) * LDZ; \
      pk[i_] = *(const bf16x8*)(Z + ro_ + kcol + cv_ * 8); pv[i_] = *(const bf16x8*)(Z + ro_ + vcol + cv_ * 8); } \
    { size_t ro_ = (size_t)chain_row(b, d, (cc) * 128 + wid * 16 + fr) * LDZ + qcol + fq * 8; \
      _Pragma("unroll") for (int kk_ = 0; kk_ < 4; ++kk_) pq[kk_] = *(const bf16x8*)(Z + ro_ + kk_ * 32); } \
    if (MODE == 0 && wid == 0) { \
      int r0_ = chain_row(b, d, (cc) * 128 + 2 * lane), r1_ = chain_row(b, d, (cc) * 128 + 2 * lane + 1); \
      gi0 = p.gates[(size_t)r0_ * 16 + d * 4 + h]; gf0 = p.gates[(size_t)r0_ * 16 + 8 + d * 4 + h]; \
      gi1 = p.gates[(size_t)r1_ * 16 + d * 4 + h]; gf1 = p.gates[(size_t)r1_ * 16 + 8 + d * 4 + h]; } } while (0)
  CHAIN_ISSUE(0);
  __syncthreads();
  for (int c = 0; c < 34; ++c) {
    if (MODE == 0 && wid == 0) {
      float i0 = gi0, f0 = gf0, i1 = gi1, f1 = gf1;
      float c1 = f0 + f1, inc = c1;
#pragma unroll
      for (int o = 1; o < 64; o <<= 1) { float t = __shfl_up(inc, o); if (lane >= o) inc += t; }
      float off = inc - c1, b0 = off + f0, b1 = off + c1;
      float a0 = i0 - b0, a1 = i1 - b1;
      float x1 = fmaxf(a0, a1), mx = x1;
#pragma unroll
      for (int o = 1; o < 64; o <<= 1) { float t = __shfl_up(mx, o); if (lane >= o) mx = fmaxf(mx, t); }
      float offm = __shfl_up(mx, 1); if (lane == 0) offm = -INFINITY;
      float M0 = fmaxf(m_prev, fmaxf(offm, a0)), M1 = fmaxf(M0, a1);
      float bL = __shfl(b1, 63), ML = __shfl(M1, 63);
      sa[2 * lane] = a0; sa[2 * lane + 1] = a1; sM[2 * lane] = M0; sM[2 * lane + 1] = M1;
      salpha[2 * lane] = expf(m_prev - M0); salpha[2 * lane + 1] = expf(m_prev - M1);
      sbeta[2 * lane] = expf(a0 - ML); sbeta[2 * lane + 1] = expf(a1 - ML);
      sclamp[2 * lane] = expf(-(b0 + M0)); sclamp[2 * lane + 1] = expf(-(b1 + M1));
      if (lane == 0) sdecay[0] = expf(m_prev - ML);
      m_prev = bL + ML;
    }
    __syncthreads();
    bf16x8 qf[4];
#pragma unroll
    for (int kk = 0; kk < 4; ++kk) qf[kk] = pq[kk];
#pragma unroll
    for (int i = 0; i < 4; ++i) {
      int idx = tid + i * 512, pr = idx >> 4, cv = idx & 15;
      *(LAS bf16x8*)(Kn + pr * PKN + cv * 8) = pk[i];
      *(LAS bf16x8*)(Vn + pr * PKV + cv * 8) = pv[i];
      float be = sbeta[pr];
      float kbf[8];
#pragma unroll
      for (int e = 0; e < 8; ++e) kbf[e] = bf2f((bf16_t)pk[i][e]) * be;
      *(LAS bf16x8*)(Kb + pr * PKB + cv * 8) = pack8(kbf);
    }
    if (c + 1 < 34) CHAIN_ISSUE(c + 1);
    __syncthreads();
    const int tq = wid * 16 + fr;
    const float Mt = sM[tq];
    bf16x8 pb[4];
    float dsum = 0.f;
#pragma unroll
    for (int ks = 0; ks < 4; ++ks) {
      pb[ks] = bf16x8{0, 0, 0, 0, 0, 0, 0, 0};
      if (2 * ks <= wid) {
#pragma unroll
        for (int hn = 0; hn < 2; ++hn) {
          const int n = 2 * ks + hn;
          f32x4 sacc = f32x4{0.f, 0.f, 0.f, 0.f};
          if (n <= wid) {
#pragma unroll
            for (int kk = 0; kk < 4; ++kk) {
              bf16x8 ka = *(const LAS bf16x8*)(Kn + (n * 16 + fr) * PKN + kk * 32 + fq * 8);
              sacc = __builtin_amdgcn_mfma_f32_16x16x32_bf16(ka, qf[kk], sacc, 0, 0, 0);
            }
          }
          const f32x4 as4 = *(const LAS f32x4*)(sa + n * 16 + fq * 4);
          f32x4 pv4;
#pragma unroll
          for (int j = 0; j < 4; ++j) {
            const int sidx = n * 16 + fq * 4 + j;
            pv4[j] = (n <= wid && sidx <= tq) ? sacc[j] * __expf(as4[j] - Mt) : 0.f;
            dsum += pv4[j];
          }
          bf16x4 pk4 = pack4(pv4);
#pragma unroll
          for (int j = 0; j < 4; ++j) pb[ks][hn * 4 + j] = pk4[j];
        }
      }
    }
    f32x4 O[NV];
    {
      const float al = salpha[tq];
#pragma unroll
      for (int nv = 0; nv < NV; ++nv) {
        f32x4 o = f32x4{0.f, 0.f, 0.f, 0.f};
#pragma unroll
        for (int kk = 0; kk < 4; ++kk) {
          bf16x8 ta = *(const LAS bf16x8*)(Tt + (nv * 16 + fr) * PKN + kk * 32 + fq * 8);
          o = __builtin_amdgcn_mfma_f32_16x16x32_bf16(ta, qf[kk], o, 0, 0, 0);
        }
        O[nv] = o * al;
      }
    }
    float den_inter = 0.f;
    if (MODE == 0) {
      den_inter = __shfl(O[NV - 1][0], fr);
      dsum += __shfl_xor(dsum, 16); dsum += __shfl_xor(dsum, 32);
    }
#pragma unroll
    for (int ks = 0; ks < 4; ++ks) {
      if (2 * ks <= wid) {
        const int r0 = 32 * ks + 4 * fq + (fr >> 2);
#pragma unroll
        for (int nv = 0; nv < NV; ++nv) {
          const int cb = nv * 32 + (fr & 3) * 8;
          bf16x8 va = tr_pair((const bf16_t*)Vn, r0 * (PKV * 2) + cb, (r0 + 16) * (PKV * 2) + cb);
          O[nv] = __builtin_amdgcn_mfma_f32_16x16x32_bf16(va, pb[ks], O[nv], 0, 0, 0);
        }
      }
    }
    {
      const int row = chain_row(b, d, c * 128 + tq);
      float inv = 1.f;
      if (MODE == 0) {
        float den = den_inter + dsum;
        inv = __builtin_amdgcn_rcpf(fmaxf(fabsf(den), sclamp[tq]));
      }
      bf16_t* op = outbuf + ((size_t)d * NT + row) * 512 + h * 128 + fq * 4;
#pragma unroll
      for (int nv = 0; nv < 8; ++nv) *(bf16x4*)(op + nv * 16) = pack4(O[nv] * inv);
    }
    {
      const float dec = sdecay[0];
#pragma unroll
      for (int nv = 0; nv < NV; ++nv) T[nv] = T[nv] * dec;
#pragma unroll
      for (int kk = 0; kk < 4; ++kk) {
        const int r0 = 32 * kk + 8 * fq + (fr >> 2);
        bf16x8 ka = tr_pair((const bf16_t*)Kb, r0 * (PKB * 2) + wid * 32 + (fr & 3) * 8, (r0 + 4) * (PKB * 2) + wid * 32 + (fr & 3) * 8);
#pragma unroll
        for (int nv = 0; nv < NV; ++nv) {
          const int cb = nv * 32 + (fr & 3) * 8;
          bf16x8 vb = tr_pair((const bf16_t*)Vn, r0 * (PKV * 2) + cb, (r0 + 4) * (PKV * 2) + cb);
          T[nv] = __builtin_amdgcn_mfma_f32_16x16x32_bf16(ka, vb, T[nv], 0, 0, 0);
        }
      }
    }
    __syncthreads();
#pragma unroll
    for (int nv = 0; nv < NV; ++nv) *(LAS bf16x4*)(Tt + (nv * 16 + fr) * PKN + wid * 16 + fq * 4) = pack4(T[nv]);
  }
#undef CHAIN_ISSUE
  __syncthreads();
}

template <bool LOCAL>
__device__ __forceinline__ void na_task(PRef p, int task, int lane) {
  constexpr int NG = LOCAL ? 2 : 1;
  const int fr = lane & 15, fq = lane >> 4;
  int b, h, r = 0, wq = 0, qrow, rs = 0, cs0 = 0;
  if (LOCAL) {
    b = task >> 11; h = (task >> 8) & 7; r = (task >> 2) & 63; wq = task & 3;
    qrow = b * 4096 + r * 64 + wq * 16 + fr;
    rs = min(max(r - 4, 0), 56);
    cs0 = wq == 0 ? 0 : (wq == 1 ? 8 : (wq == 2 ? 24 : 32));
  } else {
    b = task >> 7; h = (task >> 4) & 7;
    qrow = NL + b * 256 + (task & 15) * 16 + fr;
  }
  const bf16_t* Z = p.z;
  bf16x8 qf[2];
#pragma unroll
  for (int kk = 0; kk < 2; ++kk) qf[kk] = *(const bf16x8*)(Z + (size_t)qrow * LDZ + h * 64 + kk * 32 + fq * 8);
  f32x4 O[4];
#pragma unroll
  for (int i = 0; i < 4; ++i) O[i] = f32x4{0.f, 0.f, 0.f, 0.f};
  float m_run = -INFINITY, l_run = 0.f;
  constexpr int NGRP = LOCAL ? 4 : 2;
  bf16x8 kc0[8], kc1[8];
#define NA_KLOAD(G_) do { const int g_ = (G_); const bool l_ = LOCAL && g_ < 2; const int c_ = LOCAL ? g_ - 2 : g_; \
    _Pragma("unroll") for (int T = 0; T < 8; ++T) { \
      const int pb_ = l_ ? b * 4096 + (rs + g_ * 4 + (T >> 1)) * 64 + cs0 : NL + b * 256 + (c_ * 8 + (T & ~1)) * 16; \
      const bf16_t* kp_ = Z + (size_t)(pb_ + 8 * (fr >> 2) + (fr & 3) + 4 * (T & 1)) * LDZ + 512 + h * 64 + fq * 8; \
      kc0[T] = *(const bf16x8*)kp_; kc1[T] = *(const bf16x8*)(kp_ + 32); } } while (0)
  NA_KLOAD(0);
#pragma unroll 1
  for (int grp = 0; grp < NGRP; ++grp) {
    const bool loc = LOCAL && grp < 2;
    const int cg0 = LOCAL ? grp - 2 : grp;
    f32x4 S[8];
#pragma unroll
    for (int T = 0; T < 8; ++T) {
      f32x4 a = f32x4{0.f, 0.f, 0.f, 0.f};
      a = __builtin_amdgcn_mfma_f32_16x16x32_bf16(kc0[T], qf[0], a, 0, 0, 0);
      a = __builtin_amdgcn_mfma_f32_16x16x32_bf16(kc1[T], qf[1], a, 0, 0, 0);
      S[T] = a;
    }
    bf16x8 vf[4][4];
#pragma unroll
    for (int ks = 0; ks < 4; ++ks) {
      const int tr0 = loc ? b * 4096 + (rs + grp * 4 + ks) * 64 + cs0 : NL + b * 256 + (cg0 * 8 + 2 * ks) * 16;
#pragma unroll
      for (int dvt = 0; dvt < 4; ++dvt) vf[ks][dvt] = *(const bf16x8*)(p.vt + (size_t)(h * 64 + dvt * 16 + fr) * NT + tr0 + 8 * fq);
    }
    if (grp + 1 < NGRP) NA_KLOAD(grp + 1);
    float mx = -INFINITY;
#pragma unroll
    for (int T = 0; T < 8; ++T) {
      f32x4 a = S[T];
      if (loc) {
        int qc = wq * 16 + fr, st = min(max(qc - 8, 0), 48);
        int roff = rs + grp * 4 + (T >> 1) - r + 7;
#pragma unroll
        for (int j = 0; j < 4; ++j) {
          int kc = cs0 + 8 * fq + 4 * (T & 1) + j;
          bool valid = kc >= st && kc < st + 16;
          float bias = valid ? ((const LAS float*)smem)[roff * 31 + (kc - qc + 15)] : 0.f;
          a[j] = valid ? a[j] * 0.125f + bias : -INFINITY;
        }
      } else {
#pragma unroll
        for (int j = 0; j < 4; ++j) a[j] *= 0.125f;
      }
#pragma unroll
      for (int j = 0; j < 4; ++j) mx = fmaxf(mx, a[j]);
      S[T] = a;
    }
    mx = fmaxf(mx, __shfl_xor(mx, 16)); mx = fmaxf(mx, __shfl_xor(mx, 32));
    float m_new = fmaxf(m_run, mx);
    float scl = __expf(m_run - m_new);
    l_run *= scl;
#pragma unroll
    for (int i = 0; i < 4; ++i)
#pragma unroll
      for (int j = 0; j < 4; ++j) O[i][j] *= scl;
    m_run = m_new;
#pragma unroll
    for (int ks = 0; ks < 4; ++ks) {
      float ev[8];
#pragma unroll
      for (int j = 0; j < 4; ++j) {
        float e0 = __expf(S[2 * ks][j] - m_new), e1 = __expf(S[2 * ks + 1][j] - m_new);
        l_run += e0 + e1;
        ev[j] = e0; ev[4 + j] = e1;
      }
      bf16x8 pb = pack8(ev);
#pragma unroll
      for (int dvt = 0; dvt < 4; ++dvt) O[dvt] = __builtin_amdgcn_mfma_f32_16x16x32_bf16(vf[ks][dvt], pb, O[dvt], 0, 0, 0);
    }
  }
#undef NA_KLOAD
  l_run += __shfl_xor(l_run, 16); l_run += __shfl_xor(l_run, 32);
  float inv = __builtin_amdgcn_rcpf(l_run);
#pragma unroll
  for (int dvt = 0; dvt < 4; ++dvt) {
    *(bf16x4*)(p.ab + (size_t)qrow * 1024 + h * 64 + dvt * 16 + fq * 4) = pack4(O[dvt] * inv);
  }
}

__device__ __forceinline__ void s5_chain(PRef p, int chain, int wslot, int lane) {
  const int d = chain & 1, g = (chain >> 1) & 31, b = chain >> 6;
  const int fr = lane & 15, fq = lane >> 4;
  constexpr int BP = 36, XP = 36;
  float* Bu = (float*)(smem + wslot * 28672);
  bf16_t* X = (bf16_t*)(smem + wslot * 28672 + 128 * BP * 4);
  const int pg = (d * 32 + g) * 64 + lane;
  float ar, ai;
  float erf_, eif_;
  {
    double lr = p.lam_re[pg], li = p.lam_im[pg];
    double dt = (double)expf(p.log_dt[d * 32 + g]);
    double zr = lr * dt, zi = li * dt;
    double mag = (double)expf((float)zr);
    float sn, cs; sincos_d(zi, &sn, &cs);
    double are = mag * cs, aim = mag * sn;
    double lsq = lr * lr + li * li;
    double er = ((are - 1.0) * lr + aim * li) / lsq, ei = (aim * lr - (are - 1.0) * li) / lsq;
    ar = (float)are; ai = (float)aim; erf_ = (float)er; eif_ = (float)ei;
  }
  bf16x8 bbf[8];
#pragma unroll
  for (int ct = 0; ct < 8; ++ct) {
    const int c = ct * 16 + fr, pp = c & 63;
    const float epr = __shfl(erf_, pp), epi = __shfl(eif_, pp);
    bf16x8 v = {0, 0, 0, 0, 0, 0, 0, 0};
    if (fq < 2) {
      const size_t bo = ((size_t)(d * 32 + g) * 64 + pp) * 16 + fq * 8;
      float4 r0 = *(const float4*)(p.b_re + bo), r1 = *(const float4*)(p.b_re + bo + 4);
      float4 i0 = *(const float4*)(p.b_im + bo), i1 = *(const float4*)(p.b_im + bo + 4);
      float brv[8] = {r0.x, r0.y, r0.z, r0.w, r1.x, r1.y, r1.z, r1.w}, biv[8] = {i0.x, i0.y, i0.z, i0.w, i1.x, i1.y, i1.z, i1.w};
#pragma unroll
      for (int e = 0; e < 8; ++e) v[e] = (short)f2bf(c < 64 ? epr * brv[e] - epi * biv[e] : epr * biv[e] + epi * brv[e]);
    }
    bbf[ct] = v;
  }
  bf16x8 cf[4];
#pragma unroll
  for (int kk = 0; kk < 4; ++kk) {
    const int k0 = kk * 32 + fq * 8;
    const float* src = (k0 < 64 ? p.c_re : p.c_im) + ((size_t)(d * 32 + g) * 16 + fr) * 64 + (k0 & 63);
    const float sg = k0 < 64 ? 1.f : -1.f;
    float4 c0 = *(const float4*)src, c1 = *(const float4*)(src + 4);
    float cv[8] = {sg * c0.x, sg * c0.y, sg * c0.z, sg * c0.w, sg * c1.x, sg * c1.y, sg * c1.z, sg * c1.w};
    cf[kk] = pack8(cv);
  }
  float xr = 0.f, xi = 0.f;
  bf16_t* ys = p.vt + (size_t)d * NT * 512;
  const bf16x8 zero8 = {0, 0, 0, 0, 0, 0, 0, 0};
  bf16x8 uf[2], un[2], un2[2], un3[2];
#define S5_ULOAD(dst, SC) do { _Pragma("unroll") for (int rt = 0; rt < 2; ++rt) { dst[rt] = zero8; \
    if (fq < 2 && (SC) < 136) dst[rt] = *(const bf16x8*)(p.z + (size_t)chain_row(b, d, (SC) * 32 + rt * 16 + fr) * LDZ + g * 16 + fq * 8); } } while (0)
  S5_ULOAD(uf, 0); S5_ULOAD(un, 1); S5_ULOAD(un2, 2);
  for (int sc = 0; sc < 136; ++sc) {
    S5_ULOAD(un3, sc + 3);
#pragma unroll
    for (int rt = 0; rt < 2; ++rt)
#pragma unroll
      for (int ct = 0; ct < 8; ++ct) {
        f32x4 a = __builtin_amdgcn_mfma_f32_16x16x32_bf16(uf[rt], bbf[ct], f32x4{0.f, 0.f, 0.f, 0.f}, 0, 0, 0);
        *(f32x4*)(Bu + (ct * 16 + fr) * BP + rt * 16 + fq * 4) = a;
      }
    __builtin_amdgcn_fence(__ATOMIC_SEQ_CST, "wavefront");
    __builtin_amdgcn_wave_barrier();
#pragma unroll
    for (int g4 = 0; g4 < 8; ++g4) {
      const f32x4 br = *(const f32x4*)(Bu + lane * BP + g4 * 4), bi = *(const f32x4*)(Bu + (64 + lane) * BP + g4 * 4);
      float sr[4], si[4];
#pragma unroll
      for (int k = 0; k < 4; ++k) {
        float nr = ar * xr - ai * xi + br[k], ni = ar * xi + ai * xr + bi[k];
        xr = nr; xi = ni; sr[k] = nr; si[k] = ni;
      }
      u32x2 wr, wi;
      wr[0] = cvt_pk_bf16(sr[0], sr[1]); wr[1] = cvt_pk_bf16(sr[2], sr[3]);
      wi[0] = cvt_pk_bf16(si[0], si[1]); wi[1] = cvt_pk_bf16(si[2], si[3]);
      *(u32x2*)(X + lane * XP + g4 * 4) = wr;
      *(u32x2*)(X + (64 + lane) * XP + g4 * 4) = wi;
    }
    __builtin_amdgcn_fence(__ATOMIC_SEQ_CST, "wavefront");
    __builtin_amdgcn_wave_barrier();
#pragma unroll
    for (int tl = 0; tl < 2; ++tl) {
      f32x4 a = f32x4{0.f, 0.f, 0.f, 0.f};
#pragma unroll
      for (int kk = 0; kk < 4; ++kk) {
        const int xo = (kk * 32 + fq * 8 + (fr >> 2)) * (XP * 2) + tl * 32 + (fr & 3) * 8;
        bf16x8 xa = tr_pair((const bf16_t*)X, xo, xo + 4 * (XP * 2));
        a = __builtin_amdgcn_mfma_f32_16x16x32_bf16(xa, cf[kk], a, 0, 0, 0);
      }
#pragma unroll
      for (int j = 0; j < 4; ++j) {
        int row = chain_row(b, d, sc * 32 + tl * 16 + fq * 4 + j);
        ys[(size_t)row * 512 + g * 16 + fr] = f2bf(a[j]);
      }
    }
    __builtin_amdgcn_fence(__ATOMIC_SEQ_CST, "wavefront");
    __builtin_amdgcn_wave_barrier();
    uf[0] = un[0]; uf[1] = un[1]; un[0] = un2[0]; un[1] = un2[1]; un2[0] = un3[0]; un2[1] = un3[1];
  }
#undef S5_ULOAD
}

template <int WHAT>
__device__ __forceinline__ void phase_mix_even(PRef p, int only_chain) {
  const int nb = gridDim.x, bid = blockIdx.x;
  const int wid = tidx() >> 6, lane = tidx() & 63;
  if (WHAT != 2) { if (bid < 64) { chain_block<0>(p, bid, p.och); return; } }
  if (WHAT != 1 && !only_chain) {
    const int b2 = WHAT == 2 ? bid : bid - 64, nb2 = WHAT == 2 ? nb : nb - 64;
    const bool swz = (nb2 & 7) == 0 && WHAT == 0;
    const int xcd = b2 & 7, rank = b2 >> 3, per = nb2 >> 3;
    const int t_lo = swz ? xcd * 2048 + rank * 8 : b2 * 8, t_hi = swz ? (xcd + 1) * 2048 : 16384, t_st = swz ? per * 8 : nb2 * 8;
    for (int base = t_lo; base < t_hi; base += t_st) {
      __syncthreads();
      if (tidx() < 465) ((LAS float*)smem)[tidx()] = p.rpb[((base >> 8) & 7) * 465 + tidx()];
      __syncthreads();
      na_task<true>(p, base + wid, lane);
    }
    for (int task = b2 * 8 + wid; task < 1024; task += nb2 * 8) na_task<false>(p, task, lane);
  }
}
__device__ __forceinline__ void phase_mix_odd(PRef p, int only_chain) {
  const int nb = gridDim.x, bid = blockIdx.x;
  const int wid = tidx() >> 6, lane = tidx() & 63;
  if (bid < 64) { chain_block<1>(p, bid, p.och); return; }
  const int b2 = bid - 64, nb2 = nb - 64;
  if (wid < 4 && !only_chain) for (int ch = b2 + nb2 * wid; ch < 512; ch += nb2 * 4) s5_chain(p, ch, wid, lane);
}

template <int MODE>
__device__ __forceinline__ void phase_combine(PRef p, int nrows) {
  const int lane = tidx() & 63, wid = tidx() >> 6;
  const int ch = lane * 8;
  const float* gn = MODE == 0 ? p.ml_gn : p.ret_gn;
  float gw[8], dsk[8];
#pragma unroll
  for (int e = 0; e < 8; ++e) { gw[e] = gn[ch + e]; dsk[e] = MODE == 1 ? p.s5_d[ch + e] : 0.f; }
  for (int row0 = (blockIdx.x * 8 + wid) * 2; row0 < nrows; row0 += gridDim.x * 16) {
    bf16x8 o0[2], o1[2], zg[2], y0[2], y1[2], uu[2];
#pragma unroll
    for (int r = 0; r < 2; ++r) {
      const int row = row0 + r;
      o0[r] = *(const bf16x8*)(p.och + (size_t)row * 512 + ch);
      o1[r] = *(const bf16x8*)(p.och + ((size_t)NT + row) * 512 + ch);
      zg[r] = *(const bf16x8*)(p.z + (size_t)row * LDZ + (MODE == 0 ? 2560 : 2048) + ch);
      if (MODE == 1) {
        y0[r] = *(const bf16x8*)(p.vt + (size_t)row * 512 + ch);
        y1[r] = *(const bf16x8*)(p.vt + ((size_t)NT + row) * 512 + ch);
        uu[r] = *(const bf16x8*)(p.z + (size_t)row * LDZ + ch);
      }
    }
#pragma unroll
    for (int r = 0; r < 2; ++r) {
      const int row = row0 + r;
      float v[8], s = 0.f;
#pragma unroll
      for (int e = 0; e < 8; ++e) { v[e] = bf2f((bf16_t)o0[r][e]) + bf2f((bf16_t)o1[r][e]); s += v[e]; }
#pragma unroll
      for (int o = 8; o > 0; o >>= 1) s += __shfl_xor(s, o);
      float mu = s * (1.f / 128.f), q = 0.f;
#pragma unroll
      for (int e = 0; e < 8; ++e) { v[e] -= mu; q += v[e] * v[e]; }
#pragma unroll
      for (int o = 8; o > 0; o >>= 1) q += __shfl_xor(q, o);
      float rstd = rsqrtf(q * (1.f / 128.f) + 1e-5f);
      float ov[8];
#pragma unroll
      for (int e = 0; e < 8; ++e) {
        float zz = bf2f((bf16_t)zg[r][e]);
        float gt = MODE == 0 ? sigmoidf_(zz) : siluf_(zz);
        ov[e] = gt * v[e] * rstd * gw[e];
      }
      *(bf16x8*)(p.ab + (size_t)row * 1024 + 512 + ch) = pack8(ov);
      if (MODE == 1) {
        float gsv[8];
#pragma unroll
        for (int e = 0; e < 8; ++e) {
          float y = bf2f((bf16_t)y0[r][e]) + bf2f((bf16_t)y1[r][e]) + dsk[e] * bf2f((bf16_t)uu[r][e]);
          float t = tanhf(0.7978845608028654f * (y + 0.044715f * y * y * y));
          gsv[e] = 0.5f * y * (1.f + t);
        }
        *(bf16x8*)(p.z + (size_t)row * LDZ + ch) = pack8(gsv);
      }
    }
  }
}

__device__ __forceinline__ void phase_rope(PRef p) {
  const int lane = tidx() & 63, wid = tidx() >> 6;
  for (int row = blockIdx.x * 8 + wid; row < NT; row += gridDim.x * 8) {
    const bool lat = row < NL;
    const int t = row & 4095;
    bf16_t* zr = p.z + (size_t)row * LDZ + 512;
    bf16x8 own[2], oth[2];
#pragma unroll
    for (int it = 0; it < 2; ++it) {
      const int e0 = (lane + 64 * it) * 8;
      own[it] = *(const bf16x8*)(zr + e0);
      oth[it] = *(const bf16x8*)(zr + (e0 ^ 32));
    }
#pragma unroll
    for (int it = 0; it < 2; ++it) {
      const int e0 = (lane + 64 * it) * 8;
      const int qk = e0 >> 9, d = e0 & 127, hs = d >> 6, second = (d >> 5) & 1, i0 = d & 31;
      const int pos = hs ? (t & 63) : (t >> 6);
      float o[8];
#pragma unroll
      for (int e = 0; e < 8; ++e) {
        float xo = bf2f((bf16_t)own[it][e]), xp = bf2f((bf16_t)oth[it][e]);
        float r = xo;
        if (lat) {
          const float2 cs = *(const float2*)(p.rope + (pos * 32 + i0 + e) * 2);
          r = second ? xo * cs.x + xp * cs.y : xo * cs.x - xp * cs.y;
        }
        o[e] = qk ? r * 0.08838834764831845f : r;
      }
      *(bf16x8*)(zr + e0) = pack8(o);
    }
  }
}

#if MK_COOP
#define XB_TMO      128
#define XB_XCNT(j)  (256  + 64 * (j))
#define XB_XSUB(j)  (1280 + 64 * (j))
#define XB_XGEN(j)  (2304 + 64 * (j))
#define XB_TOP      3328
#define XB_TOPGEN   3392
#define XCD_BAR_WORDS 3456
#define XB_SPIN_CAP (1u << 21)
__device__ __forceinline__ unsigned xb_ld(unsigned* q)              { return __hip_atomic_load(q, __ATOMIC_RELAXED, __HIP_MEMORY_SCOPE_AGENT); }
__device__ __forceinline__ unsigned xb_add(unsigned* q, unsigned v) { return __hip_atomic_fetch_add(q, v, __ATOMIC_RELAXED, __HIP_MEMORY_SCOPE_AGENT); }
__device__ __forceinline__ unsigned xb_xcc_id() { return (unsigned)__builtin_amdgcn_s_getreg((3 << 11) | 20) & 0xFu; }
#define XB_SPIN(cond, bar) do { unsigned _sp = 0; while (cond) { __builtin_amdgcn_s_sleep(1); \
    if ((++_sp & 255u) == 0u) { if (xb_ld(&(bar)[XB_TMO])) break; if (_sp > XB_SPIN_CAP) { atomicAdd(&(bar)[XB_TMO], 1u); break; } } } } while (0)
__device__ __forceinline__ volatile LAS unsigned* xb_state() { return (volatile LAS unsigned*)(smem + LDS_BYTES - 16); }
__device__ __forceinline__ void xcd_barrier_complete(unsigned* bar, unsigned x, unsigned& nloc, unsigned& nx) {
  const unsigned G = gridDim.x;
  unsigned sum, cnt, mine, sp = 0u;
  for (;;) {
    sum = 0u; cnt = 0u; mine = 0u;
#pragma unroll
    for (unsigned j = 0; j < 16; ++j) { const unsigned c = xb_ld(&bar[XB_XCNT(j)]); sum += c; cnt += (c > 0u) ? 1u : 0u; mine = (j == x) ? c : mine; }
    if (sum == G) break;
    __builtin_amdgcn_s_sleep(1);
    if ((++sp & 255u) == 0u) { if (xb_ld(&bar[XB_TMO])) break; if (sp > XB_SPIN_CAP) { atomicAdd(&bar[XB_TMO], 1u); break; } }
  }
  nloc = mine > 0u ? mine : 1u; nx = cnt > 0u ? cnt : 1u;
}
__device__ __forceinline__ void xcd_barrier() {
  asm volatile("s_waitcnt vmcnt(0)" ::: "memory");
  __syncthreads();
  unsigned* bar = kparams()->bar;
  if (tidx() == 0) {
    const unsigned x = xb_xcc_id();
    volatile LAS unsigned* st = xb_state();
    __builtin_amdgcn_s_waitcnt(0);
    unsigned nloc = st[0], nx = st[1];
    if (nloc == 0u) { xcd_barrier_complete(bar, x, nloc, nx); st[0] = nloc; st[1] = nx; }
    const unsigned old = xb_add(&bar[XB_XSUB(x)], 1u);
    const unsigned gen = old / nloc;
    if (old + 1u == (gen + 1u) * nloc) {
      __builtin_amdgcn_fence(__ATOMIC_RELEASE, "agent");
      asm volatile("s_waitcnt vmcnt(0)" ::: "memory");
      const unsigned og = xb_add(&bar[XB_TOP], 1u);
      const unsigned tg = og / nx;
      if (og + 1u == (tg + 1u) * nx) xb_add(&bar[XB_TOPGEN], 1u);
      else XB_SPIN(xb_ld(&bar[XB_TOPGEN]) == tg, bar);
      __builtin_amdgcn_fence(__ATOMIC_ACQUIRE, "agent");
      xb_add(&bar[XB_XGEN(x)], 1u);
      asm volatile("s_waitcnt vmcnt(0)" ::: "memory");
    } else {
      XB_SPIN(xb_ld(&bar[XB_XGEN(x)]) == gen, bar);
      __builtin_amdgcn_fence(__ATOMIC_ACQUIRE, "agent");
      asm volatile("s_waitcnt vmcnt(0)" ::: "memory");
    }
  }
  __syncthreads();
}
#else
__device__ __forceinline__ void xcd_barrier() {}
#endif

#ifndef DIAG
#define DIAG -1
#endif
#define on_(k) ((DIAG < 0 || DIAG == (k)) && (G < 0 || G == (k)))
template <int G>
__device__ __forceinline__ void run_phase(PRef p, int ph) {
  EpiArgs ea{};
  int gem = 0, lda = 1024, K = 1024, nM = 136, nN = 4;
  const bf16_t* A = p.ab; const bf16_t* Bt = p.wgu;
  int mixed = 0, plx = 0, pml = 0, pmj = 0;
  const int only_chain = (ph == 108 || ph == 120);
  switch (ph == 108 ? 8 : ph == 120 ? 20 : ph) {
    case 0: if constexpr (on_(0)) phase_setup(p); break;
    case 1: if constexpr (on_(1)) phase_prep<0>(p, 0, 0, 0, 0, NT, blockIdx.x, gridDim.x); break;
    case 2: case 12: case 15: case 25: {
      int li = ph == 2 ? 0 : ph == 12 ? 1 : ph == 15 ? 2 : 3;
      ea.o16 = p.z; gem = 1; Bt = p.wgu + (size_t)li * 5632 * 1024; nM = ph == 25 ? 128 : 136; nN = 22;
    } break;
    case 3: case 13: case 16: case 26: {
      int li = ph == 3 ? 0 : ph == 13 ? 1 : ph == 16 ? 2 : 3;
      int l = li >> 1, j = (li & 1) * 2;
      ea.modg = p.mod + (size_t)l * 9 * 9216 + (3 * j + 2) * 1024; ea.coef = 0.5f;
      ea.lnidx = ph == 3 ? -1 : ph == 13 ? 1 : ph == 16 ? 2 : 4;
      gem = 2; A = p.z; lda = 2816; K = 2816; Bt = p.wdn + (size_t)li * 1024 * 2816; nM = 128; nN = 4;
    } break;
    case 4: case 14: case 17: {
      int li = ph == 4 ? 0 : ph == 14 ? 1 : 2;
      int l = li >> 1, j = (li & 1) * 2;
      ea.modg = p.mod + (size_t)l * 9 * 9216 + (3 * j + 2) * 1024; ea.coef = 0.5f;
      ea.lnidx = ph == 4 ? -1 : ph == 14 ? 1 : 2;
      gem = 2; A = p.z + (size_t)NL * 2816; lda = 2816; K = 2816; Bt = p.wdn + (size_t)li * 1024 * 2816; nM = 8; nN = 4;
      mixed = 1; plx = ph == 4 ? 0 : ph == 14 ? 2 : 3; pml = ph == 4 ? 0 : 1; pmj = ph == 4 ? 1 : ph == 14 ? 0 : 1;
    } break;
    case 5: ea.o16 = p.z; ea.ncol = 3088; ea.flag = 1; gem = 3; Bt = p.wevin; nN = 13; break;
    case 6: if constexpr (on_(5)) phase_mlconv(p); break;
    case 7: ea.o16 = p.z; gem = 4; A = p.och; lda = 512; K = 512; Bt = p.wqk; nN = 4; break;
    case 8: if constexpr (G < 0 && (DIAG < 0 || DIAG == 7)) phase_mix_even<0>(p, only_chain); else if constexpr (G >= 0 && on_(7)) phase_mix_even<1>(p, 0); else if constexpr (on_(13)) phase_mix_even<2>(p, 0); break;
    case 9: if constexpr (on_(8)) phase_combine<0>(p, NT); break;
    case 10: ea.modg = p.mod + (size_t)0 * 9 * 9216 + 5 * 1024; ea.coef = 1.0f; ea.lnidx = 0; gem = 2; Bt = p.wevout; nM = 128; break;
    case 11:
      ea.modg = p.mod + (size_t)0 * 9 * 9216 + 5 * 1024; ea.coef = 1.0f; ea.lnidx = 0; gem = 2; A = p.ab + (size_t)NL * 1024; Bt = p.wevout; nM = 8;
      mixed = 1; plx = 1; pml = 0; pmj = 2; break;
    case 18: ea.o16 = p.z; ea.ncol = 2560; ea.flag = 0; gem = 3; Bt = p.wodin; nN = 10; break;
    case 19: if constexpr (on_(9)) phase_rope(p); break;
    case 20: if constexpr (on_(10)) phase_mix_odd(p, only_chain); break;
    case 21: if constexpr (on_(11)) phase_combine<1>(p, NL); break;
    case 22: ea.vec = p.glu_b; gem = 5; A = p.z; lda = LDZ; K = 512; Bt = p.wglu; nM = 128; nN = 2; break;
    case 23: ea.modg = p.mod + (size_t)1 * 9 * 9216 + 5 * 1024; ea.coef = 1.0f; ea.lnidx = 3; gem = 2; Bt = p.wodout; nM = 128; break;
    case 24: if constexpr (on_(1)) phase_prep<1>(p, 4, 1, 2, 0, NL, blockIdx.x, gridDim.x); break;
    case 27: if constexpr (on_(1)) phase_prep<2>(p, 5, 0, 0, 0, NL, blockIdx.x, gridDim.x); break;
    default: break;
  }
  const int nb = gridDim.x, bid = blockIdx.x;
  const int row0 = mixed ? NL : 0;
  const int gbid = bid, gnb = mixed ? 32 : nb;
  if (ph == 102) { ea.o16 = p.z; Bt = p.wgu; nN = 22; gem = 6; }
  if (gem == 6) { if constexpr (PROBE_PH == 102) phase_gemm<6>(p, A, lda, Bt, K, nM, nN, ea, 0, bid, nb); }
  if (gem == 1) { if constexpr (on_(2)) phase_gemm<1>(p, A, lda, Bt, K, nM, nN, ea, 0, bid, nb); }
  else if (gem == 2) { if constexpr (on_(3)) { if (!mixed || bid < 32) phase_gemm<2>(p, A, lda, Bt, K, nM, nN, ea, row0, gbid, gnb); } }
  else if (gem == 3) { if constexpr (on_(4)) phase_gemm<3>(p, A, lda, Bt, K, nM, nN, ea, 0, bid, nb); }
  else if (gem == 4) { if constexpr (on_(6)) phase_gemm<4>(p, A, lda, Bt, K, nM, nN, ea, 0, bid, nb); }
  else if (gem == 5) { if constexpr (on_(12)) phase_gemm<5>(p, A, lda, Bt, K, nM, nN, ea, 0, bid, nb); }
  if (mixed) {
    if constexpr (on_(1)) {
      if (bid >= 32) phase_prep<1>(p, plx, pml, pmj, 0, NL, bid - 32, nb - 32);
      xcd_barrier();
      phase_prep<1>(p, plx, pml, pmj, NL, NT, bid, nb);
    }
  }
}

template <int G>
__global__ void __launch_bounds__(512) mega(Params p, int ph_lo, int ph_hi) {
  for (int ph = ph_lo; ph < ph_hi; ++ph) run_phase<G>(*kparams(), ph);
}

#if MK_COOP
template <int PH>
__device__ __forceinline__ void run_all(cg::grid_group& grid) {
  if constexpr (PH == 1) {
    volatile LAS unsigned* st = xb_state();
    unsigned* bar = kparams()->bar;
    if (tidx() == 0) { st[0] = 0u; st[1] = 0u; (void)xb_add(&bar[XB_XCNT(xb_xcc_id())], 1u); }
    __syncthreads();
  }
  run_phase<-1>(*kparams(), PH);
  if constexpr (PH + 1 < NPHASE) {
    if constexpr (PH == 0) grid.sync(); else xcd_barrier();
    run_all<PH + 1>(grid);
  }
}
__global__ void __launch_bounds__(512) mega_coop(Params p) {
  __builtin_assume(__builtin_amdgcn_workitem_id_y() == 0);
  __builtin_assume(__builtin_amdgcn_workitem_id_z() == 0);
  cg::grid_group grid = cg::this_grid();
  run_all<0>(grid);
#pragma unroll 1
  for (int i = 0; i < PROBE_N; ++i) { xcd_barrier(); run_phase<-1>(*kparams(), PROBE_PH); }
}
#endif

extern "C" void kernel_launch(void* const* d_in, const int* in_sizes, int n_in, void* d_out, int out_size,
                              void* d_ws, size_t ws_size, hipStream_t stream) {
  Params p{};
  const float** ip = (const float**)&p;
  for (int i = 0; i < 35; ++i) ip[i] = (const float*)d_in[i];
  p.out = (float*)d_out;
  char* w = (char*)d_ws;
  size_t off = 0;
  auto take = [&](size_t bytes) { char* r = w + off; off += (bytes + 255) & ~(size_t)255; return r; };
  p.mod = (float*)take((size_t)2 * 9 * 9216 * 4);
  p.rope = (float*)take(64 * 32 * 2 * 4);
  p.hsc = (float*)take((size_t)2048 * 1024 * 4);
  p.gates = (float*)take((size_t)NT * 16 * 4);
  p.wgu = (bf16_t*)take((size_t)4 * 5632 * 1024 * 2);
  p.wdn = (bf16_t*)take((size_t)4 * 1024 * 2816 * 2);
  p.wevin = (bf16_t*)take((size_t)3328 * 1024 * 2);
  p.wodin = (bf16_t*)take((size_t)2560 * 1024 * 2);
  p.wevout = (bf16_t*)take((size_t)1024 * 1024 * 2);
  p.wodout = (bf16_t*)take((size_t)1024 * 1024 * 2);
  p.wqk = (bf16_t*)take((size_t)1024 * 512 * 2);
  p.wglu = (bf16_t*)take((size_t)512 * 512 * 2);
  p.z = (bf16_t*)take((size_t)NT * LDZ * 2);
  p.ab = (bf16_t*)take((size_t)NT * 1024 * 2);
  p.och = (bf16_t*)take((size_t)2 * NT * 512 * 2);
  p.vt = (bf16_t*)take((size_t)2 * NT * 512 * 2);
  p.bar = (unsigned*)take((size_t)3456 * 4);
  p.stats = (float*)take((size_t)NT * 2 * 4);
  if (off > ws_size) { fprintf(stderr, "workspace too small: need %zu have %zu\n", off, ws_size); return; }
#if MK_COOP
  (void)hipFuncSetAttribute((const void*)mega_coop, hipFuncAttributeMaxDynamicSharedMemorySize, LDS_BYTES);
  int dev = 0, cus = 0, per_cu = 0;
  hipGetDevice(&dev);
  hipDeviceGetAttribute(&cus, hipDeviceAttributeMultiprocessorCount, dev);
  hipOccupancyMaxActiveBlocksPerMultiprocessor(&per_cu, mega_coop, 512, LDS_BYTES);
  int grid = cus * (per_cu > 0 ? 1 : 0);
  if (grid <= 0) { fprintf(stderr, "occupancy query failed\n"); return; }
  void* args[] = {&p};
  hipError_t e = hipLaunchCooperativeKernel((void*)mega_coop, dim3(grid), dim3(512), args, LDS_BYTES, stream);
  if (e != hipSuccess) fprintf(stderr, "cooperative launch failed: %s (grid %d)\n", hipGetErrorString(e), grid);
#else
  static const int grp[NPHASE] = {0, 1, 2, 3, 1, 4, 5, 6, 7, 8, 3, 1, 2, 3, 1, 2, 3, 1, 4, 9, 10, 11, 12, 3, 1, 2, 3, 1};
#define LG(k) case k: (void)hipFuncSetAttribute((const void*)mega<k>, hipFuncAttributeMaxDynamicSharedMemorySize, LDS_BYTES); \
    mega<k><<<256, 512, LDS_BYTES, stream>>>(p, ph, ph + 1); break;
  for (int ph = 0; ph < NPHASE; ++ph) {
    if (ph == 8) { (void)hipFuncSetAttribute((const void*)mega<13>, hipFuncAttributeMaxDynamicSharedMemorySize, LDS_BYTES);
      mega<13><<<256, 512, LDS_BYTES, stream>>>(p, ph, ph + 1); }
    switch (grp[ph]) { LG(0) LG(1) LG(2) LG(3) LG(4) LG(5) LG(6) LG(7) LG(8) LG(9) LG(10) LG(11) LG(12) }
  }
#endif
}
```
